# Optimizing an MI355X kernel written in HIP

```python
import math
import jax, jax.numpy as jnp
from jax import lax
import numpy as np

D_MODEL = 1024
BATCH = 8
SEQ = 2048
DEPTH = 2
DEC_BATCH = 4
DEC_SEQ = 4096
PAST_LEN = 128

HEAD_DIM = 64
BLOCK = 128
A_GROUPS = 8
A_WIDTH = A_GROUPS * HEAD_DIM
B_HEADS = 8
B_KV = 2
WINDOW = 128
C_HEADS = 8
C_KV = 2
ROPE_THETA = 10000.0
GRID_W = 64
N_BUCKETS = 32
MAX_DIST = 128
D_FF = 2816
CONV_W = 3
EPS = 1e-6
N_BRANCH = 3
BR_WIDTH = 512
A_IN = 2 * A_WIDTH
B_IN = (B_HEADS + 2 * B_KV) * HEAD_DIM
C_IN = (C_HEADS + 2 * C_KV) * HEAD_DIM
IN_WIDTH = A_IN + B_IN + C_IN

kernel_name = 'hybrid_gated_parallel_encoder'

f32 = jnp.float32


def rmsnorm(x, g):
    xf = x.astype(f32)
    y = xf * lax.rsqrt(jnp.mean(xf * xf, axis=-1, keepdims=True) + EPS)
    return (y * g.astype(f32)).astype(x.dtype)


def layernorm(x, g, b):
    xf = x.astype(f32)
    mu = jnp.mean(xf, axis=-1, keepdims=True)
    xc = xf - mu
    y = xc * lax.rsqrt(jnp.mean(xc * xc, axis=-1, keepdims=True) + EPS)
    return (y * g.astype(f32) + b.astype(f32)).astype(x.dtype)


def t5_bucket(rel):
    half = N_BUCKETS // 2
    max_exact = half // 2
    ret = jnp.where(rel > 0, half, 0)
    n = jnp.abs(rel)
    nf = jnp.maximum(n, 1).astype(f32)
    large = max_exact + (jnp.log(nf / max_exact) / math.log(MAX_DIST / max_exact)
                         * (half - max_exact)).astype(jnp.int32)
    large = jnp.minimum(large, half - 1)
    return ret + jnp.where(n < max_exact, n, large)


def mixer_a(z, ln_g, ln_b, w_s, b_s):
    bsz, s, _ = z.shape
    nb = s // BLOCK
    z = jax.nn.gelu(z)
    u, v = jnp.split(z, 2, axis=-1)
    v = layernorm(v, ln_g, ln_b).reshape(bsz, nb, BLOCK, A_GROUPS, HEAD_DIM)
    sv = jnp.einsum('gpq,bnqgc->bnpgc', w_s, v) + b_s.T[None, None, :, :, None]
    return u * sv.reshape(bsz, s, A_WIDTH)


def mixer_b(q, k, v, sink, bias, win):
    bsz, s = q.shape[:2]
    nb = s // BLOCK
    g = B_HEADS // B_KV

    def band(t):
        tp = jnp.pad(t, ((0, 0), (BLOCK, BLOCK), (0, 0), (0, 0)))
        tp = tp.reshape(bsz, nb + 2, BLOCK, B_KV, HEAD_DIM)
        return jnp.concatenate([tp[:, :-2], tp[:, 1:-1], tp[:, 2:]], axis=2)

    kb, vb = band(k), band(v)
    qb = q.reshape(bsz, nb, BLOCK, B_KV, g, HEAD_DIM)
    logits = jnp.einsum('bnqkgd,bnjkd->bnkgqj', qb, kb).astype(f32) * (HEAD_DIM ** -0.5)
    logits = logits + bias.reshape(B_KV, g, BLOCK, 3 * BLOCK)
    kpos = (jnp.arange(nb)[:, None] - 1) * BLOCK + jnp.arange(3 * BLOCK)[None, :]
    valid = (kpos >= 0) & (kpos < s)
    mask = win[None] & valid[:, None, :]
    logits = jnp.where(mask[None, :, None, None], logits, -jnp.inf)
    sk = sink.astype(f32).reshape(B_KV, g, 1, 1)
    m = jnp.maximum(jnp.max(logits, axis=-1, keepdims=True), sk)
    p = jnp.exp(logits - m)
    probs = p / (jnp.sum(p, axis=-1, keepdims=True) + jnp.exp(sk - m))
    o = jnp.einsum('bnkgqj,bnjkd->bnqkgd', probs.astype(v.dtype), vb)
    return o.reshape(bsz, s, B_HEADS * HEAD_DIM)


def rope_axis(x, pos):
    m = x.shape[-1] // 2
    inv = ROPE_THETA ** (-jnp.arange(m, dtype=f32) / m)
    ang = pos.astype(f32)[:, None] * inv[None, :]
    cos = jnp.cos(ang)[:, None, :]
    sin = jnp.sin(ang)[:, None, :]
    x1 = x[..., :m].astype(f32)
    x2 = x[..., m:].astype(f32)
    return jnp.concatenate([x1 * cos - x2 * sin, x2 * cos + x1 * sin], axis=-1).astype(x.dtype)


def rope_2d(x, row, col):
    h = HEAD_DIM // 2
    return jnp.concatenate([rope_axis(x[..., :h], row), rope_axis(x[..., h:], col)], axis=-1)


def mixer_c(q, k, v, qg, kg, row, col):
    bsz, s = q.shape[:2]
    nb = s // BLOCK
    g = C_HEADS // C_KV
    q = rope_2d(rmsnorm(q, qg), row, col)
    k = rope_2d(rmsnorm(k, kg), row, col)
    qb = q.reshape(bsz, nb, BLOCK, C_KV, g, HEAD_DIM).transpose(1, 0, 2, 3, 4, 5)
    scale = HEAD_DIM ** -0.5

    def attend(qblk):
        logits = jnp.einsum('bqkgd,bskd->bkgqs', qblk, k).astype(f32) * scale
        p = jax.nn.softmax(logits, axis=-1).astype(v.dtype)
        return jnp.einsum('bkgqs,bskd->bqkgd', p, v)

    o = lax.map(attend, qb)
    return o.transpose(1, 0, 2, 3, 4, 5).reshape(bsz, s, C_HEADS * HEAD_DIM)


def conv_ffn(x, w_up, cw, cb, w_down):
    h = x @ w_up
    hp = jnp.pad(h, ((0, 0), (1, 1), (0, 0)))
    h = hp[:, :-2] * cw[0] + hp[:, 1:-1] * cw[1] + hp[:, 2:] * cw[2] + cb
    gt, val = jnp.split(h, 2, axis=-1)
    return (jax.nn.silu(gt) * val) @ w_down


def trunk(x, bias_b, win, norm1_g, w_in, ln_v_g, ln_v_b, w_spatial, b_spatial, sink,
          q_norm_g, k_norm_g, w_gate, b_gate, w_branch, w_out, norm2_g, w_up, conv_w,
          conv_b, w_down, final_g):
    bsz, s, d = x.shape
    rows = s // GRID_W
    row = jnp.repeat(jnp.arange(rows), GRID_W)
    col = jnp.tile(jnp.arange(GRID_W), rows)
    hb = B_HEADS * HEAD_DIM
    kvb = B_KV * HEAD_DIM
    hc = C_HEADS * HEAD_DIM
    kvc = C_KV * HEAD_DIM
    for l in range(DEPTH):
        xn = rmsnorm(x, norm1_g[l])
        z = xn @ w_in[l]
        za = z[..., :A_IN]
        zb = z[..., A_IN:A_IN + B_IN]
        zc = z[..., A_IN + B_IN:]
        o_a = mixer_a(za, ln_v_g[l], ln_v_b[l], w_spatial[l], b_spatial[l])
        o_b = mixer_b(zb[..., :hb].reshape(bsz, s, B_HEADS, HEAD_DIM),
                      zb[..., hb:hb + kvb].reshape(bsz, s, B_KV, HEAD_DIM),
                      zb[..., hb + kvb:].reshape(bsz, s, B_KV, HEAD_DIM),
                      sink[l], bias_b, win)
        o_c = mixer_c(zc[..., :hc].reshape(bsz, s, C_HEADS, HEAD_DIM),
                      zc[..., hc:hc + kvc].reshape(bsz, s, C_KV, HEAD_DIM),
                      zc[..., hc + kvc:].reshape(bsz, s, C_KV, HEAD_DIM),
                      q_norm_g[l], k_norm_g[l], row, col)
        o = jnp.stack([o_a, o_b, o_c], axis=2)
        y = jnp.einsum('bsne,ned->bsnd', o, w_branch[l])
        gates = jax.nn.sigmoid(xn @ w_gate[l] + b_gate[l]).reshape(bsz, s, N_BRANCH, d)
        merged = jnp.sum(gates * y, axis=2)
        x = x + merged @ w_out[l]
        x = x + conv_ffn(rmsnorm(x, norm2_g[l]), w_up[l], conv_w[l], conv_b[l], w_down[l])
    return rmsnorm(x, final_g)


def setup_inputs(seed: int = 0) -> dict:
    key = jax.random.key(seed)
    ks = jax.random.split(key, 24)

    def nrm(k, shape, scale):
        return jax.random.normal(k, shape, f32) * scale

    L, D = DEPTH, D_MODEL
    return {
        'x_prompt': nrm(ks[0], (BATCH, SEQ, D), 1.0),
        'x_sample': nrm(ks[1], (DEC_BATCH, DEC_SEQ, D), 1.0),
        'rel_bias': nrm(ks[2], (N_BUCKETS, B_HEADS), 0.5),
        'norm1_g': 1.0 + nrm(ks[3], (L, D), 0.1),
        'w_in': nrm(ks[4], (L, D, IN_WIDTH), D ** -0.5),
        'ln_v_g': 1.0 + nrm(ks[5], (L, A_WIDTH), 0.1),
        'ln_v_b': nrm(ks[6], (L, A_WIDTH), 0.05),
        'w_spatial': nrm(ks[7], (L, A_GROUPS, BLOCK, BLOCK), BLOCK ** -0.5),
        'b_spatial': 1.0 + nrm(ks[8], (L, A_GROUPS, BLOCK), 0.1),
        'sink': nrm(ks[9], (L, B_HEADS), 0.5),
        'q_norm_g': 1.0 + nrm(ks[10], (L, HEAD_DIM), 0.1),
        'k_norm_g': 1.0 + nrm(ks[11], (L, HEAD_DIM), 0.1),
        'w_gate': nrm(ks[12], (L, D, N_BRANCH * D), D ** -0.5),
        'b_gate': nrm(ks[13], (L, N_BRANCH * D), 0.05),
        'w_branch': nrm(ks[14], (L, N_BRANCH, BR_WIDTH, D), BR_WIDTH ** -0.5),
        'w_out': nrm(ks[15], (L, D, D), D ** -0.5),
        'norm2_g': 1.0 + nrm(ks[16], (L, D), 0.1),
        'w_up': nrm(ks[17], (L, D, 2 * D_FF), D ** -0.5),
        'conv_w': nrm(ks[18], (L, CONV_W, 2 * D_FF), CONV_W ** -0.5),
        'conv_b': nrm(ks[19], (L, 2 * D_FF), 0.05),
        'w_down': nrm(ks[20], (L, D_FF, D), D_FF ** -0.5),
        'final_g': 1.0 + nrm(ks[21], (D,), 0.1),
    }


def reference(x_prompt, x_sample, rel_bias, norm1_g, w_in, ln_v_g, ln_v_b, w_spatial,
              b_spatial, sink, q_norm_g, k_norm_g, w_gate, b_gate, w_branch, w_out,
              norm2_g, w_up, conv_w, conv_b, w_down, final_g):
    qpos = jnp.arange(BLOCK)[:, None]
    jpos = jnp.arange(3 * BLOCK)[None, :]
    rel = jpos - BLOCK - qpos
    win = jnp.abs(rel) <= WINDOW
    bias_b = rel_bias[t5_bucket(rel)].transpose(2, 0, 1).astype(f32)
    y_prompt = trunk(x_prompt, bias_b, win, norm1_g, w_in, ln_v_g, ln_v_b, w_spatial,
                     b_spatial, sink, q_norm_g, k_norm_g, w_gate, b_gate, w_branch, w_out,
                     norm2_g, w_up, conv_w, conv_b, w_down, final_g)
    y_sample = trunk(x_sample, bias_b, win, norm1_g, w_in, ln_v_g, ln_v_b, w_spatial,
                     b_spatial, sink, q_norm_g, k_norm_g, w_gate, b_gate, w_branch, w_out,
                     norm2_g, w_up, conv_w, conv_b, w_down, final_g)
    return (y_prompt, y_sample)
```

```cpp
#include <hip/hip_runtime.h>
#include <hip/hip_cooperative_groups.h>
#include <hip/hip_bf16.h>
#include <cstdio>
#include <cstdint>
#include <cmath>
namespace cg = cooperative_groups;

constexpr int DMODEL = 1024, GT = 16384  , PITCH = 5632  , DFF = 2816;
constexpr int COL_U = 0, COL_QB = 512, COL_QC = 1024, COL_VA = 1536, COL_KB = 2048, COL_VB = 2176, COL_KC = 2304, COL_VC = 2432, COL_MERGED = 1536, COL_GATE = 2560;
constexpr float EPSN = 1e-6f;
constexpr float QK_C2 = 0.125f * 1.4426950408889634f;
__device__ __forceinline__ int otid() { int t = threadIdx.x; asm volatile("" : "+v"(t)); return t; }
__device__ __forceinline__ int obid() { int t = blockIdx.x; asm volatile("" : "+s"(t)); return t; }
__device__ __forceinline__ int ogdim() { int t = gridDim.x; asm volatile("" : "+s"(t)); return t; }

namespace pg8 {
#define PG8_LAS __attribute__((address_space(3)))
typedef unsigned short bf16_t;
typedef short bf16x8 __attribute__((ext_vector_type(8)));
typedef float f32x4 __attribute__((ext_vector_type(4)));
typedef unsigned u32x4 __attribute__((ext_vector_type(4)));
constexpr int BM = 256, BK = 64, HALF = 128, HTB = HALF * BK * 2  , STAGE_BYTES = 8 * HTB, NXCD = 8, WGM = 8;

__host__ __device__ __forceinline__ int lds_byte(int r, int c) { const int st = (r >> 4) * 2 + (c >> 5), rr = r & 15, cc = c & 31, ob = rr * 64 + cc * 2; return st * 1024 + (ob ^ (((ob >> 9) & 1) << 5)); }
__host__ __device__ __forceinline__ void stage_rc(int b, int& R, int& C) { const int st = b / 1024, sb = b % 1024, swz = sb ^ (((sb >> 9) & 1) << 5); R = (st >> 1) * 16 + swz / 64; C = (st & 1) * 32 + (swz % 64) / 2; }
__host__ __device__ __forceinline__ int perm32(int rho) { const int n = rho >> 4, i = rho & 15; return 8 * (i >> 2) + 4 * n + (i & 3); }

struct Unit { int pm, pn, ko, n, arow; };
struct Gemm { const bf16_t* A; const bf16_t* Bt; int lda, ldb, K; };


struct Order {
    int nM, nN, nwg, G, c, rep, kstep, ovl;
    __device__ void init(int M, int N, int G_, int c_, int rep_, int kstep_) { nM = M / BM; nN = N / BM; nwg = nM * nN; G = G_; c = c_; rep = rep_; kstep = kstep_; ovl = 0; }
    __device__ void init_ovl(int nM_, int N, int G_, int c_) { nM = nM_; nN = N / BM; nwg = nM * nN; G = G_; c = c_; rep = 1; kstep = 0; ovl = 1; }
    __device__ bool next(int i, Unit& u) const {
        int ti = i, n = 0; if (rep == 3) { ti = i / 3; n = i - ti * 3; }
        const long L = (long)ti * G + c; if (L >= nwg) return false;
        int wgid = (int)L; { const int q = nwg / NXCD, r = nwg % NXCD, xcd = wgid % NXCD, off = wgid / NXCD; wgid = (xcd < r ? xcd * (q + 1) : r * (q + 1) + (xcd - r) * q) + off; }
        const int nig = WGM * nN, gid = wgid / nig, fm = gid * WGM, gsz = (nM - fm) < WGM ? (nM - fm) : WGM;
        u.pm = fm + ((wgid % nig) % gsz); u.pn = (wgid % nig) / gsz; u.ko = n * kstep; u.n = n; u.arow = ovl ? (u.pm ? 254 * u.pm - 1 : 0) : u.pm * BM; return true;
    }
    __device__ __forceinline__ void a_ready(const Unit&) const {}
    __device__ __forceinline__ void done(const Unit&) const {}
};

#define PG8_GAS __attribute__((address_space(1)))
typedef PG8_GAS bf16_t* gbf_p; typedef const PG8_GAS bf16_t* gbf_cp; typedef PG8_GAS float* gf_p; typedef const PG8_GAS float* gf_cp;
__device__ __forceinline__ unsigned cvt_pk_bf16(float lo, float hi) { unsigned r; asm volatile("v_cvt_pk_bf16_f32 %0, %1, %2" : "=v"(r) : "v"(lo), "v"(hi)); return r; }
__device__ __forceinline__ float bf_lo(unsigned w) { return __uint_as_float(w << 16); }
__device__ __forceinline__ float bf_hi(unsigned w) { return __uint_as_float(w & 0xffff0000u); }
__device__ __forceinline__ float sigmoid_f(float v) { return __builtin_amdgcn_rcpf(1.0f + __builtin_amdgcn_exp2f(-1.4426950408889634f * v)); }
__device__ __forceinline__ float gelu_tanh_f(float v) { const float t = v * (1.0f + 0.044715f * v * v); return v * __builtin_amdgcn_rcpf(1.0f + __builtin_amdgcn_exp2f(-2.3022082008f * t)); }
__device__ __forceinline__ float silu_f(float v) { return v * sigmoid_f(v); }
__device__ __forceinline__ u32x4 pack8(f32x4 a, f32x4 b) { u32x4 w; w.x = cvt_pk_bf16(a[0], a[1]); w.y = cvt_pk_bf16(a[2], a[3]); w.z = cvt_pk_bf16(b[0], b[1]); w.w = cvt_pk_bf16(b[2], b[3]); return w; }

struct Epi1 {
    static constexpr bool PERM = true, AFTER_DRAIN = false;
    gbf_p O; gf_cp ssq; gf_cp bgate;
    __device__ __forceinline__ void operator()(const f32x4 (&acc)[2][2][4][2], const Unit& u, int wr, int wc, int fr, int fq) const {
        const int row0 = u.pm * BM + wr * 64 + fr, col0 = u.pn * BM + wc * 32 + 8 * fq, pn = u.pn;
        const int mode = (pn >= 10) ? 3 : ((pn < 2 || pn == 6 || pn == 7) ? 1 : ((pn == 2 || pn == 3) ? 2 : 0));
        f32x4 bv[2][2];
#pragma unroll
        for (int bj = 0; bj < 2; ++bj)
#pragma unroll
            for (int n = 0; n < 2; ++n) bv[bj][n] = (mode == 3) ? *(const PG8_GAS f32x4*)(bgate + (col0 - COL_GATE) + bj * HALF + 4 * n) : (f32x4){0.f, 0.f, 0.f, 0.f};
        float sq[2][4];
#pragma unroll
        for (int ai = 0; ai < 2; ++ai)
#pragma unroll
            for (int m = 0; m < 4; ++m) sq[ai][m] = ssq[row0 + ai * HALF + m * 16];
#pragma unroll
        for (int ai = 0; ai < 2; ++ai)
#pragma unroll
            for (int m = 0; m < 4; ++m) {
                const int row = row0 + ai * HALF + m * 16; const float rs = rsqrtf(sq[ai][m] * (1.0f / 1024.0f) + EPSN);
                gbf_p rowp = O + (size_t)row * PITCH + col0;
#pragma unroll
                for (int bj = 0; bj < 2; ++bj) {
                    f32x4 v0 = acc[ai][bj][m][0] * rs, v1 = acc[ai][bj][m][1] * rs;
                    if (mode == 1) {
#pragma unroll
                        for (int e = 0; e < 4; ++e) { v0[e] = gelu_tanh_f(v0[e]); v1[e] = gelu_tanh_f(v1[e]); }
                    } else if (mode == 2) { v0 = v0 * QK_C2; v1 = v1 * QK_C2; }
                    else if (mode == 3) { v0 = v0 + bv[bj][0]; v1 = v1 + bv[bj][1];
#pragma unroll
                        for (int e = 0; e < 4; ++e) { v0[e] = sigmoid_f(v0[e]); v1[e] = sigmoid_f(v1[e]); } }
                    *(PG8_GAS u32x4*)(rowp + bj * HALF) = pack8(v0, v1);
                }
            }
    }
};

struct Epi4 {
    static constexpr bool PERM = true, AFTER_DRAIN = false;
    gbf_p HB;
    __device__ __forceinline__ void operator()(const f32x4 (&acc)[2][2][4][2], const Unit& u, int wr, int wc, int fr, int fq) const {
        const int row0 = u.pm * BM + wr * 64 + fr, col0 = u.pn * BM + wc * 32 + 8 * fq;
#pragma unroll
        for (int ai = 0; ai < 2; ++ai) {
            u32x4 gw[4][2], mw[4][2];
#pragma unroll
            for (int m = 0; m < 4; ++m) { gbf_cp gp = HB + (size_t)(row0 + ai * HALF + m * 16) * PITCH + COL_GATE + u.n * 1024 + col0;
#pragma unroll
                for (int bj = 0; bj < 2; ++bj) gw[m][bj] = *(const PG8_GAS u32x4*)(gp + bj * HALF); }
            if (u.n > 0) {
#pragma unroll
                for (int m = 0; m < 4; ++m) { gbf_cp mp = HB + (size_t)(row0 + ai * HALF + m * 16) * PITCH + COL_MERGED + col0;
#pragma unroll
                    for (int bj = 0; bj < 2; ++bj) mw[m][bj] = *(const PG8_GAS u32x4*)(mp + bj * HALF); }
            } else {
#pragma unroll
                for (int m = 0; m < 4; ++m)
#pragma unroll
                    for (int bj = 0; bj < 2; ++bj) mw[m][bj] = (u32x4){0u, 0u, 0u, 0u};
            }
#pragma unroll
            for (int m = 0; m < 4; ++m) { gbf_p mp = HB + (size_t)(row0 + ai * HALF + m * 16) * PITCH + COL_MERGED + col0;
#pragma unroll
                for (int bj = 0; bj < 2; ++bj) { const u32x4 g = gw[m][bj], w = mw[m][bj];
                    const f32x4 v0 = acc[ai][bj][m][0] * (f32x4){bf_lo(g.x), bf_hi(g.x), bf_lo(g.y), bf_hi(g.y)} + (f32x4){bf_lo(w.x), bf_hi(w.x), bf_lo(w.y), bf_hi(w.y)};
                    const f32x4 v1 = acc[ai][bj][m][1] * (f32x4){bf_lo(g.z), bf_hi(g.z), bf_lo(g.w), bf_hi(g.w)} + (f32x4){bf_lo(w.z), bf_hi(w.z), bf_lo(w.w), bf_hi(w.w)};
                    *(PG8_GAS u32x4*)(mp + bj * HALF) = pack8(v0, v1); } }
        }
    }
};

struct Epi5 {
    static constexpr bool PERM = false, AFTER_DRAIN = false;
    gf_cp xin; gf_p xout; gbf_p xb; gf_p ssq;
    __device__ __forceinline__ void operator()(const f32x4 (&acc)[2][2][4][2], const Unit& u, int wr, int wc, int fr, int fq) const {
        typedef unsigned u32x2v __attribute__((ext_vector_type(2)));
        const int row0 = u.pm * BM + wr * 64 + fr, col0 = u.pn * BM + wc * 32 + 4 * fq;
#pragma unroll
        for (int ai = 0; ai < 2; ++ai) {
            f32x4 xv[4][2][2];
#pragma unroll
            for (int m = 0; m < 4; ++m) { const size_t off = (size_t)(row0 + ai * HALF + m * 16) * DMODEL + col0;
#pragma unroll
                for (int bj = 0; bj < 2; ++bj)
#pragma unroll
                    for (int n = 0; n < 2; ++n) xv[m][bj][n] = *(const PG8_GAS f32x4*)(xin + off + bj * HALF + n * 16); }
#pragma unroll
            for (int m = 0; m < 4; ++m) {
                const int row = row0 + ai * HALF + m * 16; const size_t off = (size_t)row * DMODEL + col0; float s = 0.f;
#pragma unroll
                for (int bj = 0; bj < 2; ++bj)
#pragma unroll
                    for (int n = 0; n < 2; ++n) { const size_t c = off + bj * HALF + n * 16; const f32x4 xn = xv[m][bj][n] + acc[ai][bj][m][n]; *(PG8_GAS f32x4*)(xout + c) = xn;
                        if (xb) { u32x2v w; w.x = cvt_pk_bf16(xn[0], xn[1]); w.y = cvt_pk_bf16(xn[2], xn[3]); *(PG8_GAS u32x2v*)(xb + c) = w; }
                        s += (xn[0] * xn[0] + xn[1] * xn[1]) + (xn[2] * xn[2] + xn[3] * xn[3]); }
                if (ssq) { s += __shfl_xor(s, 16); s += __shfl_xor(s, 32); if (fq == 0) (void)__hip_atomic_fetch_add(ssq + row, s, __ATOMIC_RELAXED, __HIP_MEMORY_SCOPE_AGENT); }
            }
        }
    }
};

struct Epi7 {
    static constexpr bool PERM = true, AFTER_DRAIN = false;
    bf16_t* O; const float* ssq; bf16_t* halo;
    __device__ __forceinline__ void operator()(const f32x4 (&acc)[2][2][4][2], const Unit& u, int wr, int wc, int fr, int fq) const {
        const int row0 = u.pm * BM + wr * 64 + fr, col0 = u.pn * BM + wc * 32 + 8 * fq;
#pragma unroll
        for (int ai = 0; ai < 2; ++ai)
#pragma unroll
            for (int m = 0; m < 4; ++m) {
                const int row = row0 + ai * HALF + m * 16; const float rs = rsqrtf(ssq[row] * (1.0f / 1024.0f) + EPSN);
                bf16_t* rowp = O + (size_t)row * PITCH + col0;
                const bool top = (m == 0 && fr == 0), bot = (m == 3 && fr == 15);
                bf16_t* hp = halo + (size_t)((row >> 6) * 2 + (bot ? 1 : 0)) * PITCH + col0;
#pragma unroll
                for (int bj = 0; bj < 2; ++bj) {
                    const u32x4 w = pack8(acc[ai][bj][m][0] * rs, acc[ai][bj][m][1] * rs);
                    *(u32x4*)(rowp + bj * HALF) = w;
                    if (top || bot) *(u32x4*)(hp + bj * HALF) = w;
                }
            }
    }
};

__device__ __forceinline__ float dpp_ror1(float x) { return __int_as_float(__builtin_amdgcn_update_dpp(0, __float_as_int(x), 0x121, 0xf, 0xf, false)); }
__device__ __forceinline__ float dpp_rol1(float x) { return __int_as_float(__builtin_amdgcn_update_dpp(0, __float_as_int(x), 0x12F, 0xf, 0xf, false)); }
struct Epi7f {
    static constexpr bool PERM = true, AFTER_DRAIN = false;
    gbf_p O; gf_cp ssq; gf_cp cw; gf_cp cb; PG8_LAS float* xl; int smask; int nrows;
    __device__ __forceinline__ void operator()(f32x4 (&acc)[2][2][4][2], const Unit& u, int wr, int wc, int fr, int fq) const {
        typedef unsigned u32x2v __attribute__((ext_vector_type(2)));
        const int lrow0 = wr * 64 + fr, arow = u.arow, olo = u.pm ? 1 : 0;
        float sq[2][4];
#pragma unroll
        for (int ai = 0; ai < 2; ++ai)
#pragma unroll
            for (int m = 0; m < 4; ++m) { int grow = arow + lrow0 + ai * HALF + m * 16; grow = grow < nrows ? grow : nrows - 1; sq[ai][m] = ssq[grow]; }
#pragma unroll
        for (int ai = 0; ai < 2; ++ai)
#pragma unroll
            for (int m = 0; m < 4; ++m) { const float rs = rsqrtf(sq[ai][m] * (1.0f / 1024.0f) + EPSN);
#pragma unroll
                for (int bj = 0; bj < 2; ++bj)
#pragma unroll
                    for (int n = 0; n < 2; ++n) acc[ai][bj][m][n] = acc[ai][bj][m][n] * rs; }
#pragma unroll
        for (int ai = 0; ai < 2; ++ai) { const int blk = 2 * ai + wr;
            if (fr == 15) { PG8_LAS float* p = xl + (((0 * 4 + blk) * 4 + wc) * 4 + fq) * 16;
#pragma unroll
                for (int bj = 0; bj < 2; ++bj)
#pragma unroll
                    for (int n = 0; n < 2; ++n) *(PG8_LAS f32x4*)(p + (bj * 2 + n) * 4) = acc[ai][bj][3][n]; }
            if (fr == 0) { PG8_LAS float* p = xl + (((1 * 4 + blk) * 4 + wc) * 4 + fq) * 16;
#pragma unroll
                for (int bj = 0; bj < 2; ++bj)
#pragma unroll
                    for (int n = 0; n < 2; ++n) *(PG8_LAS f32x4*)(p + (bj * 2 + n) * 4) = acc[ai][bj][0][n]; } }
        asm volatile("s_waitcnt lgkmcnt(0)" ::: "memory"); __builtin_amdgcn_s_barrier(); asm volatile("" ::: "memory");
#pragma unroll
        for (int n = 0; n < 2; ++n) {
            const int cg = u.pn * HALF + wc * 32 + 8 * fq + 4 * n, cv = 2816 + cg;
            const f32x4 wg0 = *(const PG8_GAS f32x4*)(cw + cg), wg1 = *(const PG8_GAS f32x4*)(cw + 5632 + cg), wg2 = *(const PG8_GAS f32x4*)(cw + 2 * 5632 + cg), bg = *(const PG8_GAS f32x4*)(cb + cg);
            const f32x4 wv0 = *(const PG8_GAS f32x4*)(cw + cv), wv1 = *(const PG8_GAS f32x4*)(cw + 5632 + cv), wv2 = *(const PG8_GAS f32x4*)(cw + 2 * 5632 + cv), bv = *(const PG8_GAS f32x4*)(cb + cv);
#pragma unroll
            for (int ai = 0; ai < 2; ++ai) { const int blk = 2 * ai + wr;
                const PG8_LAS float* pl = xl + (((0 * 4 + (blk > 0 ? blk - 1 : 0)) * 4 + wc) * 4 + fq) * 16;
                const PG8_LAS float* pf = xl + (((1 * 4 + (blk < 3 ? blk + 1 : 3)) * 4 + wc) * 4 + fq) * 16;
#pragma unroll
                for (int m = 0; m < 4; ++m) {
                    const int lrow = lrow0 + ai * HALF + m * 16, grow = arow + lrow;
                    const bool zp = (grow & smask) == 0, zn = ((grow + 1) & smask) == 0;
                    f32x4 hc[2];
#pragma unroll
                    for (int bj = 0; bj < 2; ++bj) {
                        const f32x4 cur = acc[ai][bj][m][n];
                        f32x4 pb, nb;
                        if (m > 0) pb = acc[ai][bj][m - 1][n]; else pb = *(const PG8_LAS f32x4*)(pl + (bj * 2 + n) * 4);
                        if (m < 3) nb = acc[ai][bj][m + 1][n]; else nb = *(const PG8_LAS f32x4*)(pf + (bj * 2 + n) * 4);
                        f32x4 prev, next;
#pragma unroll
                        for (int e = 0; e < 4; ++e) {
                            const float a = dpp_ror1(cur[e]), b = (m > 0) ? dpp_ror1(pb[e]) : pb[e];
                            const float c = dpp_rol1(cur[e]), d = (m < 3) ? dpp_rol1(nb[e]) : nb[e];
                            prev[e] = zp ? 0.f : (fr == 0 ? b : a); next[e] = zn ? 0.f : (fr == 15 ? d : c); }
                        hc[bj] = bj == 0 ? prev * wg0 + cur * wg1 + next * wg2 + bg : prev * wv0 + cur * wv1 + next * wv2 + bv;
                    }
                    if (lrow >= olo && lrow <= olo + 253 && grow < nrows) {
                        u32x2v w; w.x = cvt_pk_bf16(silu_f(hc[0][0]) * hc[1][0], silu_f(hc[0][1]) * hc[1][1]); w.y = cvt_pk_bf16(silu_f(hc[0][2]) * hc[1][2], silu_f(hc[0][3]) * hc[1][3]);
                        *(PG8_GAS u32x2v*)(O + (size_t)grow * PITCH + cg) = w; }
                }
            }
        }
    }
};

template <class Epi, class Sched, bool ALIGN_EPI = false, bool SP2 = false>
__device__ __forceinline__ void gemm_phase(PG8_LAS unsigned char* lds, const Gemm g, const Sched& S, const Epi& E, const int tid_in) {
    int tid = tid_in; asm volatile("" : "+v"(tid)); const int wid = __builtin_amdgcn_readfirstlane(tid >> 6), lane = tid & 63, wr = wid >> 2, wc = wid & 3, fr = lane & 15, fq = lane >> 4;
    const int K = g.K, nt = K / BK;
    unsigned voffA[2], voffB[2];
#pragma unroll
    for (int i = 0; i < 2; ++i) { int R, C; stage_rc(tid * 16 + i * 8192, R, C); const int Rb = Epi::PERM ? ((R & ~31) + perm32(R & 31)) : R;
        voffA[i] = (unsigned)(R * g.lda + C) * 2u; voffB[i] = (unsigned)(Rb * g.ldb + C) * 2u; }
    const size_t kstep = (size_t)(BK * 2);
    const size_t hstepA = (size_t)HALF * g.lda * 2, hstepB = (size_t)HALF * g.ldb * 2;
    const size_t tstepB = 2 * hstepB;
    const unsigned ldsw = (unsigned)wid * 1024u;
    const int aoff = lds_byte(wr * 64 + fr, fq * 8), boff = lds_byte(wc * 32 + fr, fq * 8);
#define PG8_SA(b, h) (((b) * 2 + (h)) * HTB)
#define PG8_SB(b, h) ((4 + (b) * 2 + (h)) * HTB)
#define PG8_STAGE(bufoff, gbase, voff) do { _Pragma("unroll") for (int _i = 0; _i < 2; ++_i) \
        __builtin_amdgcn_global_load_lds((const unsigned*)((const char*)(gbase) + (voff)[_i]), (PG8_LAS unsigned*)(lds + (bufoff) + ldsw + _i * 8192), 16, 0, 0); } while (0)
#define PG8_LDA(dst, b, h) do { _Pragma("unroll") for (int m = 0; m < 4; ++m) _Pragma("unroll") for (int k = 0; k < 2; ++k) dst[m][k] = *(const PG8_LAS bf16x8*)(lds + PG8_SA(b, h) + aoff + m * 2048 + k * 1024); } while (0)
#define PG8_LDB(dst, b, h) do { _Pragma("unroll") for (int n = 0; n < 2; ++n) _Pragma("unroll") for (int k = 0; k < 2; ++k) dst[n][k] = *(const PG8_LAS bf16x8*)(lds + PG8_SB(b, h) + boff + n * 2048 + k * 1024); } while (0)
#define PG8_MMA(ai, bj, At, Bt) do { __builtin_amdgcn_s_setprio(1); _Pragma("unroll") for (int m = 0; m < 4; ++m) _Pragma("unroll") for (int n = 0; n < 2; ++n) _Pragma("unroll") for (int k = 0; k < 2; ++k) \
        acc[ai][bj][m][n] = __builtin_amdgcn_mfma_f32_16x16x32_bf16(Bt[n][k], At[m][k], acc[ai][bj][m][n], 0, 0, 0); __builtin_amdgcn_s_setprio(0); } while (0)
#define PG8_WAIT_V(n) asm volatile("s_waitcnt vmcnt(" #n ")" ::: "memory")
#define PG8_WAIT_L(n) asm volatile("s_waitcnt lgkmcnt(" #n ")" ::: "memory")
#define PG8_BAR __builtin_amdgcn_s_barrier()
#define PG8_SCHED __builtin_amdgcn_sched_barrier(0)
    Unit cur, nxt; int ui = 0;
    if (!S.next(0, cur)) return;
    f32x4 acc[2][2][4][2];
#pragma unroll
    for (int a = 0; a < 2; ++a)
#pragma unroll
        for (int b = 0; b < 2; ++b)
#pragma unroll
            for (int m = 0; m < 4; ++m)
#pragma unroll
                for (int n = 0; n < 2; ++n) acc[a][b][m][n] = (f32x4){0.f, 0.f, 0.f, 0.f};
    bf16x8 At[4][2], B0[2][2], B1[2][2];
    const char* cA = (const char*)g.A + (size_t)cur.arow * (size_t)g.lda * 2 + (size_t)cur.ko * 2; const char* cB = (const char*)g.Bt + (size_t)cur.pn * tstepB + (size_t)cur.ko * 2;
    S.a_ready(cur);
    if constexpr (SP2) {
        PG8_STAGE(PG8_SB(0, 0), cB, voffB); PG8_STAGE(PG8_SB(0, 1), cB + hstepB, voffB); PG8_STAGE(PG8_SA(0, 0), cA, voffA); PG8_STAGE(PG8_SA(0, 1), cA + hstepA, voffA);
        if (wr == 1) PG8_BAR;
        PG8_WAIT_V(2); PG8_BAR;
        PG8_STAGE(PG8_SB(1, 0), cB + kstep, voffB); PG8_STAGE(PG8_SA(1, 0), cA + kstep, voffA); PG8_STAGE(PG8_SB(1, 1), cB + hstepB + kstep, voffB);
        PG8_WAIT_V(6); PG8_BAR;
    } else {
        PG8_STAGE(PG8_SB(0, 0), cB, voffB); PG8_STAGE(PG8_SA(0, 0), cA, voffA); PG8_STAGE(PG8_SB(0, 1), cB + hstepB, voffB); PG8_STAGE(PG8_SA(0, 1), cA + hstepA, voffA);
        if (wr == 1) PG8_BAR;
        PG8_WAIT_V(4); PG8_BAR;
        PG8_STAGE(PG8_SB(1, 0), cB + kstep, voffB); PG8_STAGE(PG8_SA(1, 0), cA + kstep, voffA); PG8_STAGE(PG8_SB(1, 1), cB + hstepB + kstep, voffB);
        PG8_WAIT_V(6); PG8_BAR;
    }
    for (;;) {
        const bool has_next = S.next(ui + 1, nxt);
        const char* nA = has_next ? (const char*)g.A + (size_t)nxt.arow * (size_t)g.lda * 2 + (size_t)nxt.ko * 2 : cA; const char* nB = has_next ? (const char*)g.Bt + (size_t)nxt.pn * tstepB + (size_t)nxt.ko * 2 : cB;
        for (int t = 0; t < nt; t += 2) {
            const bool last = (t == nt - 2);
            const char* a1 = cA + (size_t)(t + 1) * kstep;
            const char* a2 = last ? nA : cA + (size_t)(t + 2) * kstep; const char* b2 = last ? nB : cB + (size_t)(t + 2) * kstep;
            const char* a3 = a2 + kstep; const char* b3 = b2 + kstep;
            if (last && has_next) S.a_ready(nxt);
            if constexpr (SP2) {
            PG8_LDB(B0, 0, 0); PG8_LDB(B1, 0, 1); PG8_SCHED; PG8_LDA(At, 0, 0); PG8_STAGE(PG8_SA(1, 1), a1 + hstepA, voffA);
            PG8_WAIT_V(8); PG8_WAIT_L(0); PG8_BAR; PG8_MMA(0, 0, At, B0); PG8_MMA(0, 1, At, B1); PG8_BAR; PG8_SCHED;
            PG8_LDA(At, 0, 1); PG8_STAGE(PG8_SB(0, 0), b2, voffB); PG8_STAGE(PG8_SB(0, 1), b2 + hstepB, voffB); PG8_STAGE(PG8_SA(0, 0), a2, voffA);
            PG8_WAIT_V(8); PG8_WAIT_L(0); PG8_BAR; PG8_MMA(1, 0, At, B0); PG8_MMA(1, 1, At, B1); PG8_BAR; PG8_SCHED;
            PG8_LDB(B0, 1, 0); PG8_LDB(B1, 1, 1); PG8_SCHED; PG8_LDA(At, 1, 0); PG8_STAGE(PG8_SA(0, 1), a2 + hstepA, voffA);
            PG8_WAIT_V(8); PG8_WAIT_L(0); PG8_BAR; PG8_MMA(0, 0, At, B0); PG8_MMA(0, 1, At, B1); PG8_BAR; PG8_SCHED;
            PG8_LDA(At, 1, 1); PG8_STAGE(PG8_SB(1, 0), b3, voffB); PG8_STAGE(PG8_SB(1, 1), b3 + hstepB, voffB); PG8_STAGE(PG8_SA(1, 0), a3, voffA);
            PG8_WAIT_V(8); PG8_WAIT_L(0); PG8_BAR; PG8_MMA(1, 0, At, B0); PG8_MMA(1, 1, At, B1); PG8_BAR; PG8_SCHED;
            } else {
            PG8_LDB(B0, 0, 0); PG8_SCHED; PG8_LDA(At, 0, 0); PG8_STAGE(PG8_SA(1, 1), a1 + hstepA, voffA);
            PG8_WAIT_L(8); PG8_BAR; PG8_WAIT_L(0); PG8_MMA(0, 0, At, B0); PG8_BAR; PG8_SCHED;
            PG8_LDB(B1, 0, 1); PG8_STAGE(PG8_SB(0, 0), b2, voffB);
            PG8_BAR; PG8_WAIT_L(0); PG8_MMA(0, 1, At, B1); PG8_BAR;
            PG8_LDA(At, 0, 1); PG8_STAGE(PG8_SA(0, 0), a2, voffA);
            PG8_BAR; PG8_WAIT_L(0); PG8_MMA(1, 0, At, B0); PG8_BAR; PG8_SCHED;
            PG8_STAGE(PG8_SB(0, 1), b2 + hstepB, voffB);
            PG8_WAIT_V(6); PG8_BAR; PG8_MMA(1, 1, At, B1); PG8_BAR;
            PG8_LDB(B0, 1, 0); PG8_SCHED; PG8_LDA(At, 1, 0); PG8_STAGE(PG8_SA(0, 1), a2 + hstepA, voffA);
            PG8_WAIT_L(8); PG8_BAR; PG8_WAIT_L(0); PG8_MMA(0, 0, At, B0); PG8_BAR; PG8_SCHED;
            PG8_LDB(B1, 1, 1); PG8_STAGE(PG8_SB(1, 0), b3, voffB);
            PG8_BAR; PG8_WAIT_L(0); PG8_MMA(0, 1, At, B1); PG8_BAR;
            PG8_LDA(At, 1, 1); PG8_STAGE(PG8_SA(1, 0), a3, voffA);
            PG8_BAR; PG8_WAIT_L(0); PG8_MMA(1, 0, At, B0); PG8_BAR; PG8_SCHED;
            PG8_STAGE(PG8_SB(1, 1), b3 + hstepB, voffB);
            PG8_WAIT_V(6); PG8_BAR; PG8_MMA(1, 1, At, B1); PG8_BAR;
            }
        }
        if constexpr (ALIGN_EPI) { if (wr == 0) PG8_BAR; }
        if constexpr (!Epi::AFTER_DRAIN) { E(acc, cur, wr, wc, fr, fq); S.done(cur); }
        if (!has_next) break;
#pragma unroll
        for (int a = 0; a < 2; ++a)
#pragma unroll
            for (int b = 0; b < 2; ++b)
#pragma unroll
                for (int m = 0; m < 4; ++m)
#pragma unroll
                    for (int n = 0; n < 2; ++n) acc[a][b][m][n] = (f32x4){0.f, 0.f, 0.f, 0.f};
        cur = nxt; cA = nA; cB = nB; ++ui;
        if constexpr (ALIGN_EPI) { if (wr == 1) PG8_BAR; }
    }
    PG8_WAIT_V(0);
    if constexpr (!ALIGN_EPI) { if (wr == 0) PG8_BAR; }
    PG8_BAR;
    if constexpr (Epi::AFTER_DRAIN) { E.fused(acc, cur, wr, wc, fr, fq, lds, wid, lane); S.done(cur); }
#undef PG8_SA
#undef PG8_SB
#undef PG8_STAGE
#undef PG8_LDA
#undef PG8_LDB
#undef PG8_MMA
#undef PG8_WAIT_V
#undef PG8_WAIT_L
#undef PG8_BAR
#undef PG8_SCHED
}
}
namespace attn_body {
using bf16=__hip_bfloat16;
using bf16x8=__attribute__((ext_vector_type(8)))short;
using s16x4=__attribute__((ext_vector_type(4)))short;
using f32x16=__attribute__((ext_vector_type(16)))float;
using u32x4=__attribute__((ext_vector_type(4)))unsigned;
constexpr int D=64,DM=5632;
constexpr int NW=8,QBLK=32,QB=QBLK*NW,KVBLK=64;
constexpr int ATTN_PITCH=DM, ATTN_UNIT_ROWS=QB;
__device__ __forceinline__ int crow(int r,int hi){return (r&3)+8*(r>>2)+4*hi;}
#define SBAR() __builtin_amdgcn_sched_barrier(0)
__device__ __forceinline__ void cmask(f32x16&p0,f32x16&p1,int jb,int qrel,int hi){
  const float NEG=-INFINITY; int kb=64*jb+4*hi;
  #pragma unroll
  for(int r=0;r<16;++r){int kv=kb+(r&3)+8*(r>>2); if(kv>qrel)p0[r]=NEG; if(kv+32>qrel)p1[r]=NEG;}
}

typedef __attribute__((address_space(3))) const float* lds_fptr;
__device__ __forceinline__ void bmask(f32x16&p0,f32x16&p1,int rel0,lds_fptr tab){
  float bb[16];
  #pragma unroll
  for(int r=0;r<16;++r){ const int rel=rel0+(r&3)+8*(r>>2); bb[r]=tab[min(max(rel+128,0),256)]; }
  __builtin_amdgcn_sched_barrier(0);
  #pragma unroll
  for(int r=0;r<16;++r){ const int rel=rel0+(r&3)+8*(r>>2); p0[r]=((unsigned)(rel+128)<=256u)?p0[r]+bb[r]:-1000.f; }
  __builtin_amdgcn_sched_barrier(0);
  #pragma unroll
  for(int r=0;r<16;++r){ const int rel=rel0+32+(r&3)+8*(r>>2); bb[r]=tab[min(max(rel+128,0),256)]; }
  __builtin_amdgcn_sched_barrier(0);
  #pragma unroll
  for(int r=0;r<16;++r){ const int rel=rel0+32+(r&3)+8*(r>>2); p1[r]=((unsigned)(rel+128)<=256u)?p1[r]+bb[r]:-1000.f; }
}
constexpr int NSLOT=3, SLOTB=8192;
constexpr int LDS_K=0, LDS_V=NSLOT*SLOTB, LDS_WS=2*NSLOT*SLOTB, LDS_OST=LDS_WS+NW*64*4, LDS_BYTES=LDS_OST+NW*4096;
constexpr float C2=0.125f*1.4426950408889634f;
__device__ __forceinline__ void glds16(const void*gsrc,unsigned lds_dst){unsigned keep;
  asm volatile("s_mov_b32 %0, m0\n\ts_mov_b32 m0, %2\n\ts_nop 0\n\tglobal_load_lds_dwordx4 %1, off\n\ts_mov_b32 m0, %0":"=&s"(keep):"v"(gsrc),"s"(lds_dst):"memory");}
__device__ __forceinline__ float max3f(float a,float b,float c){float r;asm("v_max3_f32 %0, %1, %2, %3":"=v"(r):"v"(a),"v"(b),"v"(c));return r;}
__device__ __forceinline__ float max2f(float a,float b){float r;asm("v_max_f32_e32 %0, %1, %2":"=v"(r):"v"(a),"v"(b));return r;}
__device__ __forceinline__ float fadd_s(float a,float b){float r;asm("v_add_f32_e32 %0, %1, %2":"=v"(r):"v"(a),"v"(b));return r;}
__device__ __forceinline__ float fsub_s(float a,float b){float r;asm("v_sub_f32_e32 %0, %1, %2":"=v"(r):"v"(a),"v"(b));return r;}
typedef float f32x2_t __attribute__((ext_vector_type(2))); typedef __bf16 bf16x2_t __attribute__((ext_vector_type(2)));
__device__ __forceinline__ unsigned cvtpk_s(float lo,float hi){f32x2_t v={lo,hi};bf16x2_t b=__builtin_convertvector(v,bf16x2_t);return __builtin_bit_cast(unsigned,b);}
#define WAIT_BAR(N) asm volatile("s_waitcnt vmcnt(" #N ") lgkmcnt(0)\n\ts_barrier":::"memory")

__device__ __forceinline__ void qkt(f32x16&p0,f32x16&p1,const char*Kslot,const bf16x8*qr,const f32x16&negm,int r32,int hi){
  const char*kb=Kslot+hi*1024+r32*16;
  #pragma unroll
  for(int d0=0;d0<4;++d0){
    const bf16x8 b0=*reinterpret_cast<const bf16x8*>(kb+d0*2048);
    const bf16x8 b1=*reinterpret_cast<const bf16x8*>(kb+d0*2048+512);
    if(d0==0){p0=__builtin_amdgcn_mfma_f32_32x32x16_bf16(b0,qr[0],negm,0,0,0);p1=__builtin_amdgcn_mfma_f32_32x32x16_bf16(b1,qr[0],negm,0,0,0);}
    else{p0=__builtin_amdgcn_mfma_f32_32x32x16_bf16(b0,qr[d0],p0,0,0,0);p1=__builtin_amdgcn_mfma_f32_32x32x16_bf16(b1,qr[d0],p1,0,0,0);}}
}
typedef __attribute__((address_space(3))) const char* lds_cptr;
typedef short v4i16_t __attribute__((ext_vector_type(4)));
__device__ __forceinline__ void kload8(bf16x8*kf,lds_cptr kp){
  kf[0]=*(const __attribute__((address_space(3))) bf16x8*)(kp);      kf[1]=*(const __attribute__((address_space(3))) bf16x8*)(kp+512);
  kf[2]=*(const __attribute__((address_space(3))) bf16x8*)(kp+2048); kf[3]=*(const __attribute__((address_space(3))) bf16x8*)(kp+2560);
  kf[4]=*(const __attribute__((address_space(3))) bf16x8*)(kp+4096); kf[5]=*(const __attribute__((address_space(3))) bf16x8*)(kp+4608);
  kf[6]=*(const __attribute__((address_space(3))) bf16x8*)(kp+6144); kf[7]=*(const __attribute__((address_space(3))) bf16x8*)(kp+6656);
}
__device__ __forceinline__ void kload2(bf16x8*kf,lds_cptr kp,int j){ kf[2*j]=*(const __attribute__((address_space(3))) bf16x8*)(kp+j*2048); kf[2*j+1]=*(const __attribute__((address_space(3))) bf16x8*)(kp+j*2048+512); }
__device__ __forceinline__ s16x4 vtr(lds_cptr p){ return __builtin_bit_cast(s16x4,__builtin_amdgcn_ds_read_tr16_b64_v4i16((__attribute__((address_space(3))) v4i16_t*)p)); }
__device__ __forceinline__ float rowmax(const f32x16&p0,const f32x16&p1){
  float a=max3f(p0[0],p0[1],p1[0]),b=max3f(p0[2],p0[3],p1[1]);a=max3f(a,p1[2],p1[3]);
  #pragma unroll
  for(int r=4;r<16;r+=4){a=max3f(a,p0[r],p0[r+1]);b=max3f(b,p0[r+2],p0[r+3]);a=max3f(a,p1[r],p1[r+1]);b=max3f(b,p1[r+2],p1[r+3]);}
  const float m=max2f(a,b);
  auto rr=__builtin_amdgcn_permlane32_swap(__float_as_uint(m),__float_as_uint(m),false,false);
  return max2f(__uint_as_float(rr[0]),__uint_as_float(rr[1]));
}
__device__ __forceinline__ void pv(f32x16*o,int vb,bf16x8 pa0,bf16x8 pa1,bf16x8 pa2,bf16x8 pa3){
  #pragma unroll
  for(int d0=0;d0<2;++d0){s16x4 lo[4],hi[4];
    #pragma unroll
    for(int ks=0;ks<4;++ks){
      asm volatile("ds_read_b64_tr_b16 %0,%1 offset:%c2":"=&v"(lo[ks]):"v"(vb),"i"(d0*4096+ks*1024):"memory");
      asm volatile("ds_read_b64_tr_b16 %0,%1 offset:%c2":"=&v"(hi[ks]):"v"(vb),"i"(d0*4096+ks*1024+512):"memory");}
    asm volatile("s_waitcnt lgkmcnt(0)":::"memory");SBAR();
    #define PK(k) (bf16x8){lo[k][0],lo[k][1],lo[k][2],lo[k][3],hi[k][0],hi[k][1],hi[k][2],hi[k][3]}
    o[d0]=__builtin_amdgcn_mfma_f32_32x32x16_bf16(pa0,PK(0),o[d0],0,0,0);
    o[d0]=__builtin_amdgcn_mfma_f32_32x32x16_bf16(pa1,PK(1),o[d0],0,0,0);
    o[d0]=__builtin_amdgcn_mfma_f32_32x32x16_bf16(pa2,PK(2),o[d0],0,0,0);
    o[d0]=__builtin_amdgcn_mfma_f32_32x32x16_bf16(pa3,PK(3),o[d0],0,0,0);
    #undef PK
  }
}

#ifndef ATTN_STORE16
#define ATTN_STORE16(p,v) (*(u32x4*)(p)=(v))
#endif
template<int THRL,int MODE> __device__ __forceinline__ void attn_unit(long rowbase,int q0,int kt0,int NT,const bf16*Q,const bf16*__restrict__ K,const bf16*__restrict__ V,bf16*O,char*shm,lds_fptr btab,float sinkl2,const int tid_in){
  int tid=tid_in; asm volatile("":"+v"(tid)); const int lane=tid&63,r32=lane&31,hi=lane>>5; const int wid=__builtin_amdgcn_readfirstlane(tid>>6);
    const bf16*Qw=Q+(rowbase+q0+wid*QBLK)*DM;
  const bf16*Kh=K+(rowbase+kt0)*DM,*Vh=V+(rowbase+kt0)*DM;
  const unsigned lds0=(unsigned)(uintptr_t)shm;
  float*wsf=(float*)(shm+LDS_WS)+wid*64;
  const bf16*ksrc=Kh+(long)lane*DM+wid*8;
  const bf16*vsrc=Vh+(long)(16*(wid&3)+(lane>>2))*DM+(wid>>2)*32+(lane&3)*8;
  const unsigned kdst=lds0+LDS_K+wid*1024, vdst=lds0+LDS_V+wid*1024;
  #define DMA_K(t,slot) glds16(ksrc+(long)(t)*KVBLK*DM,(unsigned)__builtin_amdgcn_readfirstlane(kdst+(slot)))
  #define DMA_V(t,slot) glds16(vsrc+(long)(t)*KVBLK*DM,(unsigned)__builtin_amdgcn_readfirstlane(vdst+(slot)))
  const int vb0=(int)(lds0+LDS_V)+((lane>>4)&1)*32+(lane&3)*8+(4*hi+((lane&15)>>2))*64;
  const char*Kbase=shm+LDS_K; bf16x8 kf[8];
  const lds_cptr shm3=(lds_cptr)shm; const lds_cptr kp0=shm3+LDS_K+hi*1024+r32*16; const lds_cptr vp0=shm3+LDS_V+((lane>>4)&1)*32+(lane&3)*8+(4*hi+((lane&15)>>2))*64;
  DMA_K(0,0);DMA_V(0,0);DMA_K(1,SLOTB);
  bf16x8 qr[4];
  #pragma unroll
  for(int d0=0;d0<4;++d0)qr[d0]=*reinterpret_cast<const bf16x8*>(&Qw[(long)r32*DM+d0*16+hi*8]);
  float mhat=0.f,l_reg=0.f;f32x16 o[2];o[0]=f32x16{};o[1]=f32x16{};f32x16 negm=f32x16{};asm volatile("":"+v"(negm));
  const int qrel=wid*QBLK+r32;
  #define CMASK(P0,P1,t) do{ if(MODE==1) bmask(P0,P1,kt0+64*(t)+4*hi-(q0+qrel),btab); }while(0)
  bool resc=false;
  #define START(P0,P1) do{ const float rm=rowmax(P0,P1); resc=false; \
    { const float dl=rm; mhat=fadd_s(mhat,dl); \
      _Pragma("unroll") for(int r=0;r<16;++r){P0[r]=fsub_s(P0[r],dl);P1[r]=fsub_s(P1[r],dl);} \
      _Pragma("unroll") for(int r=0;r<16;++r)negm[r]=-mhat; asm volatile("":"+v"(negm)); } \
    _Pragma("unroll") for(int r=0;r<16;++r)P0[r]=__builtin_amdgcn_exp2f(P0[r]); }while(0)
  #define RESC() do{ if(resc){ asm volatile("s_waitcnt lgkmcnt(0)":::"memory"); \
      _Pragma("unroll") for(int d_=0;d_<2;++d_) _Pragma("unroll") for(int r=0;r<16;++r)o[d_][r]*=wsf[crow(r,hi)]; } }while(0)
  f32x16 pA0,pA1,pB0,pB1;
  int sl_prev=0,sl_cur=0,sl_next=SLOTB;
  #define ROT() do{sl_prev=sl_cur;sl_cur=sl_next;sl_next=(sl_next==(NSLOT-1)*SLOTB)?0:sl_next+SLOTB;}while(0)
  DMA_K(2,2*SLOTB);
  WAIT_BAR(3);
  qkt(pA0,pA1,Kbase,qr,negm,r32,hi);asm volatile("s_nop 15\n\ts_nop 7":"+v"(pA0),"+v"(pA1));CMASK(pA0,pA1,0);
  START(pA0,pA1);
  _Pragma("unroll") for(int r=0;r<16;++r)pA1[r]=__builtin_amdgcn_exp2f(pA1[r]);
  WAIT_BAR(0);
  DMA_K(3,0);DMA_V(1,SLOTB);
  ROT();
  kload8(kf,kp0+sl_cur);
  WAIT_BAR(2);
  s16x4 vlo[8],vhi[8]; u32x4 pw0,pw1,pw2,pw3;
  #define PKW(P,B) cvtpk_s(P[B],P[B+1])
  #define PAF(k) __builtin_bit_cast(bf16x8,pw##k)
  #define VFR(i) (bf16x8){vlo[i][0],vlo[i][1],vlo[i][2],vlo[i][3],vhi[i][0],vhi[i][1],vhi[i][2],vhi[i][3]}
  #define PIN(x) asm volatile("":"+v"(x))
  #define MX3(a,b,c) __builtin_fmaxf(__builtin_fmaxf((a),(b)),(c))
  #define GAPA(MF,A0,A1,A2,A3,W0,W1,PW) do{ MF; sacc+=A0; sacc+=A1; sacc+=A2; sacc+=A3; PIN(sacc); W0; W1; PIN(PW); SBAR(); }while(0)
  #define EX(v) __builtin_amdgcn_exp2f(v)
  #define GAPB(MF,X,B) do{ MF; X[B]=EX(X[B]); X[B+1]=EX(X[B+1]); X[B+2]=EX(X[B+2]); X[B+3]=EX(X[B+3]); PIN(X); SBAR(); }while(0)
  #define VRD(i) do{ vlo[i]=vtr(vp_+(((i)>>2)*4096+((i)&3)*1024)); vhi[i]=vtr(vp_+(((i)>>2)*4096+((i)&3)*1024+512)); }while(0)
  #define KRD(G,j) do{ if(G){ kload2(kf,kp0+sl_next,j); SBAR(); } }while(0)
  #define STEP(C0,C1,P0,P1,t,GK,GV,GL) do{ SBAR(); \
    const lds_cptr vp_=vp0+sl_prev; \
    VRD(0); SBAR(); float sacc=(P0[0]+P0[1]); \
    GAPA(C0=__builtin_amdgcn_mfma_f32_32x32x16_bf16(kf[0],qr[0],negm,0,0,0), P0[2],P0[3],P0[4],P0[5],     pw0[0]=PKW(P0,0), pw0[1]=PKW(P0,2), pw0); \
    VRD(4); SBAR(); GAPA(C1=__builtin_amdgcn_mfma_f32_32x32x16_bf16(kf[1],qr[0],negm,0,0,0), P0[6],P0[7],P0[8],P0[9],     pw0[2]=PKW(P0,4), pw0[3]=PKW(P0,6), pw0); \
    VRD(1); SBAR(); GAPA(C0=__builtin_amdgcn_mfma_f32_32x32x16_bf16(kf[2],qr[1],C0,0,0,0),   P0[10],P0[11],P0[12],P0[13], pw1[0]=PKW(P0,8), pw1[1]=PKW(P0,10), pw1); \
    VRD(5); SBAR(); GAPA(C1=__builtin_amdgcn_mfma_f32_32x32x16_bf16(kf[3],qr[1],C1,0,0,0),   P0[14],P0[15],P1[0],P1[1],   pw1[2]=PKW(P0,12),pw1[3]=PKW(P0,14), pw1); \
    VRD(2); SBAR(); GAPA(C0=__builtin_amdgcn_mfma_f32_32x32x16_bf16(kf[4],qr[2],C0,0,0,0),   P1[2],P1[3],P1[4],P1[5],     pw2[0]=PKW(P1,0), pw2[1]=PKW(P1,2), pw2); \
    VRD(6); SBAR(); GAPA(C1=__builtin_amdgcn_mfma_f32_32x32x16_bf16(kf[5],qr[2],C1,0,0,0),   P1[6],P1[7],P1[8],P1[9],     pw2[2]=PKW(P1,4), pw2[3]=PKW(P1,6), pw2); \
    VRD(3); SBAR(); GAPA(C0=__builtin_amdgcn_mfma_f32_32x32x16_bf16(kf[6],qr[3],C0,0,0,0),   P1[10],P1[11],P1[12],P1[13], pw3[0]=PKW(P1,8), pw3[1]=PKW(P1,10), pw3); \
    VRD(7); SBAR(); GAPA(C1=__builtin_amdgcn_mfma_f32_32x32x16_bf16(kf[7],qr[3],C1,0,0,0),   P1[14],P1[15],0.f,0.f,       pw3[2]=PKW(P1,12),pw3[3]=PKW(P1,14), pw3); \
    l_reg+=sacc; \
    if(GK){DMA_K((t)+3,sl_cur);} if(GV){DMA_V((t)+1,sl_next);} \
    CMASK(C0,C1,t); \
    { float a=MX3(C0[0],C0[1],C1[0]),b=MX3(C0[2],C0[3],C1[1]); a=MX3(a,C1[2],C1[3]); \
      _Pragma("unroll") for(int r=4;r<16;r+=4){a=MX3(a,C0[r],C0[r+1]);b=MX3(b,C0[r+2],C0[r+3]);a=MX3(a,C1[r],C1[r+1]);b=MX3(b,C1[r+2],C1[r+3]);} \
      float rm=__builtin_fmaxf(a,b); { auto rr=__builtin_amdgcn_permlane32_swap(__float_as_uint(rm),__float_as_uint(rm),false,false); rm=__builtin_fmaxf(__uint_as_float(rr[0]),__uint_as_float(rr[1])); } \
      resc=false; \
      if(__builtin_expect(__any(rm>(float)THRL),0)){ const float dl=__builtin_fmaxf(rm,0.f); mhat+=dl; \
        _Pragma("unroll") for(int r=0;r<16;++r){C0[r]-=dl;C1[r]-=dl;} \
        _Pragma("unroll") for(int r=0;r<16;++r)negm[r]=-mhat; asm volatile("":"+v"(negm)); \
        const float f=__builtin_amdgcn_exp2f(-dl); l_reg*=f; if(hi==0)wsf[r32]=f; resc=true; } } \
    SBAR(); \
    GAPB(o[0]=__builtin_amdgcn_mfma_f32_32x32x16_bf16(PAF(0),VFR(0),o[0],0,0,0), C0,0); \
    GAPB(o[1]=__builtin_amdgcn_mfma_f32_32x32x16_bf16(PAF(0),VFR(4),o[1],0,0,0), C0,4); \
    KRD(GL,0); GAPB(o[0]=__builtin_amdgcn_mfma_f32_32x32x16_bf16(PAF(1),VFR(1),o[0],0,0,0), C0,8); \
    KRD(GL,1); GAPB(o[1]=__builtin_amdgcn_mfma_f32_32x32x16_bf16(PAF(1),VFR(5),o[1],0,0,0), C0,12); \
    KRD(GL,2); GAPB(o[0]=__builtin_amdgcn_mfma_f32_32x32x16_bf16(PAF(2),VFR(2),o[0],0,0,0), C1,0); \
    KRD(GL,3); GAPB(o[1]=__builtin_amdgcn_mfma_f32_32x32x16_bf16(PAF(2),VFR(6),o[1],0,0,0), C1,4); \
    GAPB(o[0]=__builtin_amdgcn_mfma_f32_32x32x16_bf16(PAF(3),VFR(3),o[0],0,0,0), C1,8); \
    GAPB(o[1]=__builtin_amdgcn_mfma_f32_32x32x16_bf16(PAF(3),VFR(7),o[1],0,0,0), C1,12); \
    }while(0)
  int t=1;
  for(;t+5<NT;t+=2){
    STEP(pB0,pB1,pA0,pA1,t,true,true,true);     WAIT_BAR(2); RESC(); ROT();
    STEP(pA0,pA1,pB0,pB1,t+1,true,true,true);   WAIT_BAR(2); RESC(); ROT();
  }
  #define ENDW(tt) do{ if((tt)+3<NT){WAIT_BAR(2);} else if((tt)+2<NT){WAIT_BAR(1);} else {WAIT_BAR(0);} }while(0)
  for(;t+1<NT;t+=2){
    STEP(pB0,pB1,pA0,pA1,t,(t+3<NT),(t+1<NT),(t+1<NT));       ENDW(t);   RESC(); ROT();
    STEP(pA0,pA1,pB0,pB1,t+1,(t+4<NT),(t+2<NT),(t+2<NT));     ENDW(t+1); RESC(); ROT();
  }
  STEP(pB0,pB1,pA0,pA1,NT-1,false,false,false); RESC();
  { float sacc=pB0[0]+pB0[1]; _Pragma("unroll") for(int r=2;r<16;++r)sacc+=pB0[r]; _Pragma("unroll") for(int r=0;r<16;++r)sacc+=pB1[r]; l_reg+=sacc;
    pw0=(u32x4){PKW(pB0,0),PKW(pB0,2),PKW(pB0,4),PKW(pB0,6)};pw1=(u32x4){PKW(pB0,8),PKW(pB0,10),PKW(pB0,12),PKW(pB0,14)};pw2=(u32x4){PKW(pB1,0),PKW(pB1,2),PKW(pB1,4),PKW(pB1,6)};pw3=(u32x4){PKW(pB1,8),PKW(pB1,10),PKW(pB1,12),PKW(pB1,14)};
    SBAR(); pv(o,vb0+sl_cur,PAF(0),PAF(1),PAF(2),PAF(3)); }
  #undef PKW
  #undef PAF
  #undef VFR
  #undef PIN
  #undef MX3
  #undef GAPA
  #undef GAPB
  #undef EX
  #undef VRD
  #undef KRD
  #undef STEP
  #undef ENDW
  {auto rr=__builtin_amdgcn_permlane32_swap(__float_as_uint(l_reg),__float_as_uint(l_reg),false,false);l_reg=__uint_as_float(rr[0])+__uint_as_float(rr[1]);}
  if(MODE==1) l_reg+=__builtin_amdgcn_exp2f(sinkl2-mhat);
  if(hi==0)wsf[32+r32]=l_reg;asm volatile("s_waitcnt lgkmcnt(0)":::"memory");
  float rli[16];
  #pragma unroll
  for(int r=0;r<16;++r)rli[r]=__builtin_amdgcn_rcpf(wsf[32+crow(r,hi)]);
  bf16*Ow=O+(rowbase+q0+wid*QBLK)*DM;
  { bf16*stg=(bf16*)(shm+LDS_OST)+wid*2048;
    #pragma unroll
    for(int r=0;r<16;++r){const int orow=crow(r,hi);
      #pragma unroll
      for(int d0=0;d0<2;++d0)stg[orow*64+d0*32+r32]=__float2bfloat16(o[d0][r]*rli[r]);}
    asm volatile("s_waitcnt lgkmcnt(0)":::"memory");
    #pragma unroll
    for(int i=0;i<4;++i){const int row=i*8+(lane>>3),ch=lane&7; const u32x4 v=*(const u32x4*)(stg+row*64+ch*8); ATTN_STORE16(Ow+(long)row*DM+ch*8,v);} }
  asm volatile("s_waitcnt lgkmcnt(0)\n\ts_barrier":::"memory");
  #undef DMA_K
  #undef DMA_V
  #undef CMASK
  #undef START
  #undef RESC
  #undef ROT
}
constexpr int ATTN_LDS_BYTES=LDS_BYTES;
#undef SBAR
#undef WAIT_BAR
}
#define LAS __attribute__((address_space(3)))
typedef unsigned short bf16_t;
typedef unsigned u32x4 __attribute__((ext_vector_type(4)));
typedef unsigned u32x2 __attribute__((ext_vector_type(2)));
typedef float f32x4 __attribute__((ext_vector_type(4)));
typedef short bf16x8 __attribute__((ext_vector_type(8)));

#ifndef MK_MULTI
#define MK_MULTI 0
#endif
#ifndef PROBE
#define PROBE 0
#endif
#ifndef PH_MASK
#define PH_MASK 0xFFFF
#endif
#define PHON(k) ((MASK >> (k)) & 1)
constexpr int NWAVES = 8, NTHR = 512, LDS_BYTES = 147456;
constexpr int NPH = 2 * 16 + 1;
constexpr size_t WS_HB = 0;
constexpr size_t WS_XB = WS_HB + (size_t)GT * PITCH * 2;
constexpr size_t WS_W1 = WS_XB + (size_t)GT * DMODEL * 2;
constexpr size_t WS_WB = WS_W1 + (size_t)5632 * 1024 * 2;
constexpr size_t WS_WO = WS_WB + (size_t)1024 * 1536 * 2;
constexpr size_t WS_WU = WS_WO + (size_t)1024 * 1024 * 2;
constexpr size_t WS_WD = WS_WU + (size_t)5632 * 1024 * 2;
constexpr size_t WS_HALO = WS_WD + (size_t)1024 * 2816 * 2;
constexpr size_t WS_SSQ1 = WS_HALO + (size_t)512 * PITCH * 2;
constexpr size_t WS_SSQ2 = WS_SSQ1 + (size_t)GT * 4;
constexpr size_t WS_BAR = WS_SSQ2 + (size_t)GT * 4;
constexpr size_t WS_END = WS_BAR + 16384;
static_assert(WS_END <= 268435456, "workspace map exceeds 256 MiB");

struct Params { const float* in[22]; float* out; unsigned char* ws; int lo, hi; };
enum { I_XP = 0, I_XS, I_RELB, I_N1G, I_WIN, I_LNG, I_LNB, I_WSP, I_BSP, I_SINK, I_QNG, I_KNG, I_WGATE, I_BGATE, I_WBR, I_WOUT, I_N2G, I_WUP, I_CW, I_CB, I_WDN, I_FING };

__device__ __forceinline__ const float* inp(const Params& P, int i) { asm volatile("" : "+s"(i)); return P.in[i]; }
__device__ __forceinline__ float wave_sum(float v) {
#pragma unroll
    for (int o = 1; o < 64; o <<= 1) v += __shfl_xor(v, o);
    return v;
}
__device__ __forceinline__ float bflo(unsigned w) { return __uint_as_float(w << 16); }
__device__ __forceinline__ float bfhi(unsigned w) { return __uint_as_float(w & 0xffff0000u); }
__device__ __forceinline__ unsigned short f2bf1(float f) { return (unsigned short)(pg8::cvt_pk_bf16(f, 0.f) & 0xffffu); }

struct WTile { const float* W; const float* gk; bf16_t* WT; int K, N, k0, n0, drow0; };
__device__ __forceinline__ WTile wprep_desc(const Params& P, unsigned char* ws, int l, int it) {
    WTile d; int r = it;
    const float* g1 = inp(P, I_N1G) + l * 1024; const float* g2 = inp(P, I_N2G) + l * 1024;
    if (r < 640) { const int kb = r / 40, nb = r % 40, sb = nb >> 1; const int db = sb < 4 ? sb : sb < 8 ? sb + 8 : sb < 12 ? sb - 4 : sb < 14 ? sb + 4 : sb < 18 ? sb - 6 : sb;
        d.W = inp(P, I_WIN) + (size_t)l * 1024 * 2560; d.K = 1024; d.N = 2560; d.k0 = kb * 64; d.n0 = nb * 64; d.gk = g1; d.WT = (bf16_t*)(ws + WS_W1); d.drow0 = db * 128 + (nb & 1) * 64; return d; } r -= 640;
    if (r < 768) { const int kb = r / 48, nb = r % 48; d.W = inp(P, I_WGATE) + (size_t)l * 1024 * 3072; d.K = 1024; d.N = 3072; d.k0 = kb * 64; d.n0 = nb * 64; d.gk = g1; d.WT = (bf16_t*)(ws + WS_W1); d.drow0 = 2560 + nb * 64; return d; } r -= 768;
    if (r < 384) { const int kb = r / 16, nb = r % 16; d.W = inp(P, I_WBR) + (size_t)l * 1536 * 1024; d.K = 1536; d.N = 1024; d.k0 = kb * 64; d.n0 = nb * 64; d.gk = nullptr; d.WT = (bf16_t*)(ws + WS_WB); d.drow0 = nb * 64; return d; } r -= 384;
    if (r < 256) { const int kb = r / 16, nb = r % 16; d.W = inp(P, I_WOUT) + (size_t)l * 1024 * 1024; d.K = 1024; d.N = 1024; d.k0 = kb * 64; d.n0 = nb * 64; d.gk = nullptr; d.WT = (bf16_t*)(ws + WS_WO); d.drow0 = nb * 64; return d; } r -= 256;
    if (r < 1408) { const int kb = r / 88, nb = r % 88; const int nv = nb >= 44 ? nb - 44 : nb;
        d.W = inp(P, I_WUP) + (size_t)l * 1024 * 5632; d.K = 1024; d.N = 5632; d.k0 = kb * 64; d.n0 = nb * 64; d.gk = g2; d.WT = (bf16_t*)(ws + WS_WU); d.drow0 = 256 * (nv >> 1) + (nb >= 44 ? 128 : 0) + 64 * (nv & 1); return d; } r -= 1408;
    { const int kb = r / 16, nb = r % 16; d.W = inp(P, I_WDN) + (size_t)l * 2816 * 1024; d.K = 2816; d.N = 1024; d.k0 = kb * 64; d.n0 = nb * 64; d.gk = nullptr; d.WT = (bf16_t*)(ws + WS_WD); d.drow0 = nb * 64; return d; }
}
__device__ __forceinline__ void wprep_load(const WTile& d, float (&v)[8], int tid) {
#pragma unroll
    for (int i = 0; i < 8; ++i) { const int kk = i * 8 + (tid >> 6), nn = tid & 63; float x = d.W[(size_t)(d.k0 + kk) * d.N + d.n0 + nn]; if (d.gk) x *= d.gk[d.k0 + kk]; v[i] = x; }
}
__device__ __forceinline__ void ph_wprep(const Params& P, int bid, int G, unsigned char* ws, int l, LAS unsigned char* lds, int tid) {
    asm volatile("" : "+v"(tid)); asm volatile("" : "+s"(bid)); asm volatile("" : "+s"(G));
    LAS float* scr = (LAS float*)lds;
    int it = bid; if (it >= 4160) return;
    WTile d = wprep_desc(P, ws, l, it); float v[8]; wprep_load(d, v, tid);
#pragma unroll 1
    for (;;) {
#pragma unroll
        for (int i = 0; i < 8; ++i) { const int kk = i * 8 + (tid >> 6), nn = tid & 63; scr[kk * 65 + nn] = v[i]; }
        __syncthreads();
        const WTile cur = d; const int nit = it + G; const bool more = nit < 4160;
        if (more) { d = wprep_desc(P, ws, l, nit); wprep_load(d, v, tid); }
        { const int n = tid >> 3, c = tid & 7; const LAS float* s = scr + (8 * c) * 65 + n;
          u32x4 o; o.x = pg8::cvt_pk_bf16(s[0], s[65]); o.y = pg8::cvt_pk_bf16(s[130], s[195]); o.z = pg8::cvt_pk_bf16(s[260], s[325]); o.w = pg8::cvt_pk_bf16(s[390], s[455]);
          *(u32x4*)(cur.WT + (size_t)(cur.drow0 + n) * cur.K + cur.k0 + 8 * c) = o; }
        __syncthreads();
        if (!more) break;
        it = nit;
    }
}

__device__ __forceinline__ void ph_p1(int bid, int G, unsigned char* ws, const float* xsrc, int tid) {
    asm volatile("" : "+v"(tid)); asm volatile("" : "+s"(bid)); asm volatile("" : "+s"(G));
    const int lane = tid & 63, wave = tid >> 6; bf16_t* XB = (bf16_t*)(ws + WS_XB); float* ssq1 = (float*)(ws + WS_SSQ1); float* ssq2 = (float*)(ws + WS_SSQ2);
    const int NGW = G * NWAVES;
    for (int row = bid * NWAVES + wave; row < GT; row += 2 * NGW) {
        const int row2 = row + NGW; const bool has2 = row2 < GT;
        const f32x4* xr = (const f32x4*)(xsrc + (size_t)row * DMODEL) + lane; const f32x4* xr2 = (const f32x4*)(xsrc + (size_t)(has2 ? row2 : row) * DMODEL) + lane;
        f32x4 v[4], v2[4]; float s = 0.f, s2 = 0.f;
#pragma unroll
        for (int j = 0; j < 4; ++j) { v[j] = xr[64 * j]; v2[j] = xr2[64 * j]; }
#pragma unroll
        for (int j = 0; j < 4; ++j) { s += (v[j].x * v[j].x + v[j].y * v[j].y) + (v[j].z * v[j].z + v[j].w * v[j].w); s2 += (v2[j].x * v2[j].x + v2[j].y * v2[j].y) + (v2[j].z * v2[j].z + v2[j].w * v2[j].w); }
        s = wave_sum(s); s2 = wave_sum(s2);
        u32x2* o = (u32x2*)(XB + (size_t)row * DMODEL) + lane;
#pragma unroll
        for (int j = 0; j < 4; ++j) { u32x2 w; w.x = pg8::cvt_pk_bf16(v[j].x, v[j].y); w.y = pg8::cvt_pk_bf16(v[j].z, v[j].w); o[64 * j] = w; }
        if (lane == 0) { ssq1[row] = s; ssq2[row] = 0.f; }
        if (has2) {
            u32x2* o2 = (u32x2*)(XB + (size_t)row2 * DMODEL) + lane;
#pragma unroll
            for (int j = 0; j < 4; ++j) { u32x2 w; w.x = pg8::cvt_pk_bf16(v2[j].x, v2[j].y); w.y = pg8::cvt_pk_bf16(v2[j].z, v2[j].w); o2[64 * j] = w; }
            if (lane == 0) { ssq1[row2] = s2; ssq2[row2] = 0.f; }
        }
    }
}

__device__ __forceinline__ void mixer_a_item(const Params& P, int l, int it, int par, bf16_t* HB, LAS unsigned char* lds, int tid) {
    const int ch = it >> 3, g8 = it & 7, r0 = ch * 128, lane = tid & 63, w = tid >> 6;
    LAS bf16_t* vT = (LAS bf16_t*)(lds + 16384 + par * 17408);
    const float* wsp = inp(P, I_WSP) + (((size_t)l * 8 + g8) * 128 + 16 * w + (lane & 15)) * 128 + 8 * (lane >> 4);
    f32x4 araw[8];
#pragma unroll
    for (int ks = 0; ks < 4; ++ks) { araw[2 * ks] = *(const f32x4*)(wsp + ks * 32); araw[2 * ks + 1] = *(const f32x4*)(wsp + ks * 32 + 4); }
    bf16_t* ub = HB + (size_t)(r0 + 16 * w + (lane & 15)) * PITCH + COL_U + g8 * 64 + 4 * (lane >> 4);
    u32x2 uraw[4];
#pragma unroll
    for (int nb = 0; nb < 4; ++nb) uraw[nb] = *(const u32x2*)(ub + 16 * nb);
    const float bs1 = inp(P, I_BSP)[((size_t)l * 8 + g8) * 128 + 16 * w + (lane & 15)];
    {
        const int q = tid >> 2, part = tid & 3;
        const bf16_t* vp = HB + (size_t)(r0 + q) * PITCH + COL_VA + part * 128;
        const int c0 = part * 16; const bf16_t* gp = HB + (size_t)(r0 + q) * PITCH + COL_VA + g8 * 64 + c0;
        const float* lg = inp(P, I_LNG) + l * 512 + g8 * 64 + c0; const float* lb = inp(P, I_LNB) + l * 512 + g8 * 64 + c0;
        u32x4 sv[16], gvw[2]; f32x4 lgv[4], lbv[4];
#pragma unroll
        for (int i = 0; i < 16; ++i) sv[i] = *(const u32x4*)(vp + 8 * i);
#pragma unroll
        for (int hh = 0; hh < 2; ++hh) gvw[hh] = *(const u32x4*)(gp + 8 * hh);
#pragma unroll
        for (int i = 0; i < 4; ++i) { lgv[i] = *(const f32x4*)(lg + 4 * i); lbv[i] = *(const f32x4*)(lb + 4 * i); }
        __builtin_amdgcn_sched_barrier(0);
        float s = 0.f, s2 = 0.f;
#pragma unroll
        for (int i = 0; i < 16; ++i) {
#pragma unroll
            for (int e = 0; e < 4; ++e) { const float a = bflo(sv[i][e]), b = bfhi(sv[i][e]); s += a + b; s2 += a * a + b * b; } }
        s += __shfl_xor(s, 1); s += __shfl_xor(s, 2); s2 += __shfl_xor(s2, 1); s2 += __shfl_xor(s2, 2);
        const float mean = s * (1.0f / 512.0f), var = fmaxf(s2 * (1.0f / 512.0f) - mean * mean, 0.f), rstd = rsqrtf(var + EPSN);
#pragma unroll
        for (int hh = 0; hh < 2; ++hh) { const u32x4 wv = gvw[hh];
#pragma unroll
            for (int e = 0; e < 4; ++e) { const int i = hh * 8 + e * 2;
                const float ga = lgv[i >> 2][i & 3], gb = lgv[(i + 1) >> 2][(i + 1) & 3], ba = lbv[i >> 2][i & 3], bb = lbv[(i + 1) >> 2][(i + 1) & 3];
                const float y0 = (bflo(wv[e]) - mean) * rstd * ga + ba, y1 = (bfhi(wv[e]) - mean) * rstd * gb + bb;
                vT[(c0 + i) * 136 + q] = f2bf1(y0); vT[(c0 + i + 1) * 136 + q] = f2bf1(y1); } }
    }
    __builtin_amdgcn_sched_barrier(0);
    bf16x8 afr[4];
#pragma unroll
    for (int ks = 0; ks < 4; ++ks) { const u32x4 aw = pg8::pack8(araw[2 * ks], araw[2 * ks + 1]); afr[ks] = __builtin_bit_cast(bf16x8, aw); }
    __syncthreads();
    f32x4 acc[4];
#pragma unroll
    for (int nb = 0; nb < 4; ++nb) acc[nb] = (f32x4){0.f, 0.f, 0.f, 0.f};
#pragma unroll
    for (int ks = 0; ks < 4; ++ks) {
#pragma unroll
        for (int nb = 0; nb < 4; ++nb) { const bf16x8 b = *(const LAS bf16x8*)(vT + (16 * nb + (lane & 15)) * 136 + ks * 32 + 8 * (lane >> 4));
            acc[nb] = __builtin_amdgcn_mfma_f32_16x16x32_bf16(b, afr[ks], acc[nb], 0, 0, 0); }
        __builtin_amdgcn_sched_barrier(0);
    }
#pragma unroll
    for (int nb = 0; nb < 4; ++nb) {
        u32x2 o; o.x = pg8::cvt_pk_bf16(bflo(uraw[nb].x) * (acc[nb][0] + bs1), bfhi(uraw[nb].x) * (acc[nb][1] + bs1)); o.y = pg8::cvt_pk_bf16(bflo(uraw[nb].y) * (acc[nb][2] + bs1), bfhi(uraw[nb].y) * (acc[nb][3] + bs1));
        *(u32x2*)(ub + 16 * nb) = o;
        __builtin_amdgcn_sched_barrier(0); }
}
__device__ __forceinline__ void ph_p3a(const Params& P, int bid, int G, unsigned char* ws, int l, int g, LAS unsigned char* lds, int tid, const int mode = 0) {
    asm volatile("" : "+v"(tid)); asm volatile("" : "+s"(bid)); asm volatile("" : "+s"(G));
    bf16_t* HB = (bf16_t*)(ws + WS_HB);
    LAS float* tab = (LAS float*)lds;
    for (int e = tid; e < 1024; e += NTHR) { const int pos = e >> 4, i = e & 15; const float inv = __builtin_amdgcn_exp2f(-(float)i * (13.287712379549449f / 16.0f)), rev = (float)pos * inv * 0.15915494309189535f; tab[2 * e] = __builtin_amdgcn_cosf(rev); tab[2 * e + 1] = __builtin_amdgcn_sinf(rev); }
    __syncthreads();
    if (mode != 2) { int par = 0;
#pragma unroll 1
      for (int i = 0, it0 = bid; it0 < 1024; ++i, it0 += G) {
          int it = it0; if (G == 256) { const int x = bid & 7, j = (bid >> 3) + 32 * i; it = ((x * 16 + (j >> 3)) << 3) + (j & 7); }
          mixer_a_item(P, l, it, par, HB, lds, tid); par ^= 1; } }
    __syncthreads();
    const int S = g == 0 ? 2048 : 4096;
    if (mode != 1)
    for (int idx = bid * NTHR + tid; idx < GT * 20; idx += G * NTHR) {
        const int half = idx & 1, th = idx >> 1, t = th / 10, hh = th - t * 10; const bool isq = hh < 8;
        bf16_t* p = HB + (size_t)t * PITCH + (isq ? COL_QC + hh * 64 : COL_KC + (hh - 8) * 64) + half * 32;
        const float* gain = (isq ? inp(P, I_QNG) : inp(P, I_KNG)) + l * 64 + half * 32; const float sc = isq ? QK_C2 : 1.0f;
        float x[32]; float ssq = 0.f;
        u32x4 xw[4]; f32x4 gvv[8];
#pragma unroll
        for (int i = 0; i < 4; ++i) xw[i] = *(const u32x4*)(p + 8 * i);
#pragma unroll
        for (int i = 0; i < 8; ++i) gvv[i] = *(const f32x4*)(gain + 4 * i);
        __builtin_amdgcn_sched_barrier(0);
#pragma unroll
        for (int i = 0; i < 4; ++i) {
#pragma unroll
            for (int e = 0; e < 4; ++e) { x[8 * i + 2 * e] = bflo(xw[i][e]); x[8 * i + 2 * e + 1] = bfhi(xw[i][e]); } }
#pragma unroll
        for (int i = 0; i < 32; ++i) ssq += x[i] * x[i];
        ssq += __shfl_xor(ssq, 1);
        const float rstd = rsqrtf(ssq * (1.0f / 64.0f) + EPSN);
#pragma unroll
        for (int i = 0; i < 8; ++i) {
#pragma unroll
            for (int e = 0; e < 4; ++e) x[4 * i + e] = x[4 * i + e] * rstd * gvv[i][e]; }
        const int ts = t & (S - 1), pos = half ? (ts & 63) : (ts >> 6);
#pragma unroll
        for (int i = 0; i < 16; ++i) { const float cs = tab[(pos * 16 + i) * 2], sn = tab[(pos * 16 + i) * 2 + 1]; const float x1 = x[i], x2 = x[16 + i];
            x[i] = (x1 * cs - x2 * sn) * sc; x[16 + i] = (x2 * cs + x1 * sn) * sc; }
#pragma unroll
        for (int i = 0; i < 4; ++i) { u32x4 wv;
#pragma unroll
            for (int e = 0; e < 4; ++e) wv[e] = pg8::cvt_pk_bf16(x[8 * i + 2 * e], x[8 * i + 2 * e + 1]);
            *(u32x4*)(p + 8 * i) = wv; }
    }
}

__device__ __forceinline__ int t5_bucket(int rel) {
    const int n = rel < 0 ? -rel : rel; int b;
    if (n < 8) b = n; else { b = 8 + (n >= 12) + (n >= 16) + (n >= 23) + (n >= 32) + (n >= 46) + (n >= 64) + (n >= 91); }
    return b + (rel > 0 ? 16 : 0);
}
constexpr int BT_OFF = 86016, BT_PITCH = 260;
__device__ __forceinline__ void ph_p3b(const Params& P, int bid, int G, unsigned char* ws, int l, int g, unsigned char* lds_gen, LAS unsigned char* lds, int tid, const int which = 0) {
    asm volatile("" : "+v"(tid)); asm volatile("" : "+s"(bid)); asm volatile("" : "+s"(G));
    using abf = attn_body::bf16;
    LAS float* bt = (LAS float*)(lds + BT_OFF);
    for (int e = tid; e < 8 * 257; e += NTHR) { const int h = e / 257, i = e - h * 257; bt[h * BT_PITCH + i] = inp(P, I_RELB)[t5_bucket(i - 128) * 8 + h] * 1.4426950408889634f; }
    __syncthreads();
    const abf* HB = (const abf*)(ws + WS_HB); abf* HBw = (abf*)(ws + WS_HB);
    const int S = g == 0 ? 2048 : 4096;
    if (which != 2)
    for (int u = bid; u < 512; u += G) {
        const int h = u & 7, r = (u >> 3) * 256, q0 = r & (S - 1); const long rowbase = r - q0;
        attn_body::attn_unit<8, 0>(rowbase, q0, 0, S / 64, HB + COL_QC + h * 64, HB + COL_KC + (h >> 2) * 64, HB + COL_VC + (h >> 2) * 64, HBw + COL_QC + h * 64, (char*)lds_gen, (attn_body::lds_fptr)bt, 0.f, tid);
    }
    if (which != 1)
    for (int u = bid; u < 512; u += G) {
        const int h = u & 7, r = (u >> 3) * 256, q0 = r & (S - 1); const long rowbase = r - q0;
        const int kt0 = q0 >= 128 ? q0 - 128 : 0, kend = (q0 + 384 <= S) ? q0 + 384 : S;
        attn_body::attn_unit<8, 1>(rowbase, q0, kt0, (kend - kt0) / 64, HB + COL_QB + h * 64, HB + COL_KB + (h >> 2) * 64, HB + COL_VB + (h >> 2) * 64, HBw + COL_QB + h * 64, (char*)lds_gen,
                                   (attn_body::lds_fptr)(bt + h * BT_PITCH), inp(P, I_SINK)[l * 8 + h] * 1.4426950408889634f, tid);
    }
}

__device__ __forceinline__ void unpack8(const u32x4 w, float (&o)[8]) {
#pragma unroll
    for (int e = 0; e < 4; ++e) { o[2 * e] = bflo(w[e]); o[2 * e + 1] = bfhi(w[e]); }
}
__device__ __forceinline__ void ph_conv(const Params& P, int bid, int G, unsigned char* ws, int l, int g, int tid) {
    asm volatile("" : "+v"(tid)); asm volatile("" : "+s"(bid)); asm volatile("" : "+s"(G));
    bf16_t* HB = (bf16_t*)(ws + WS_HB); const bf16_t* halo = (const bf16_t*)(ws + WS_HALO);
    const int S = g == 0 ? 2048 : 4096;
    const float* cw = inp(P, I_CW) + (size_t)l * 3 * 5632; const float* cb = inp(P, I_CB) + (size_t)l * 5632;
    for (int gt = bid * NTHR + tid; gt < 256 * 352; gt += G * NTHR) {
        const int rb = gt / 352, ci = gt - rb * 352, r0 = rb * 64, cg0 = ci * 8, cv0 = DFF + ci * 8;
        float wg[3][8], wv[3][8], bg[8], bv[8];
#pragma unroll
        for (int k = 0; k < 3; ++k)
#pragma unroll
            for (int e = 0; e < 8; ++e) { wg[k][e] = cw[k * 5632 + cg0 + e]; wv[k][e] = cw[k * 5632 + cv0 + e]; }
#pragma unroll
        for (int e = 0; e < 8; ++e) { bg[e] = cb[cg0 + e]; bv[e] = cb[cv0 + e]; }
        const bool topz = (r0 & (S - 1)) == 0, botz = ((r0 + 64) & (S - 1)) == 0;
        float pgt[8], pvl[8], cgt[8], cvl[8];
        if (topz) {
#pragma unroll
            for (int e = 0; e < 8; ++e) { pgt[e] = 0.f; pvl[e] = 0.f; }
        } else { const bf16_t* hp = halo + (size_t)((rb - 1) * 2 + 1) * PITCH; unpack8(*(const u32x4*)(hp + cg0), pgt); unpack8(*(const u32x4*)(hp + cv0), pvl); }
        { const bf16_t* rp = HB + (size_t)r0 * PITCH; unpack8(*(const u32x4*)(rp + cg0), cgt); unpack8(*(const u32x4*)(rp + cv0), cvl); }
#pragma unroll 1
        for (int rr = 0; rr < 64; rr += 8) {
            u32x4 ng[8], nv[8];
#pragma unroll
            for (int j = 0; j < 8; ++j) {
                if (rr + j + 1 < 64) { const bf16_t* rp = HB + (size_t)(r0 + rr + j + 1) * PITCH; ng[j] = *(const u32x4*)(rp + cg0); nv[j] = *(const u32x4*)(rp + cv0); }
                else if (botz) { ng[j] = (u32x4){0u, 0u, 0u, 0u}; nv[j] = (u32x4){0u, 0u, 0u, 0u}; }
                else { const bf16_t* hp = halo + (size_t)((rb + 1) * 2) * PITCH; ng[j] = *(const u32x4*)(hp + cg0); nv[j] = *(const u32x4*)(hp + cv0); }
            }
#pragma unroll
            for (int j = 0; j < 8; ++j) {
                float ngt[8], nvl[8]; unpack8(ng[j], ngt); unpack8(nv[j], nvl);
                float o[8];
#pragma unroll
                for (int e = 0; e < 8; ++e) { const float a = pgt[e] * wg[0][e] + cgt[e] * wg[1][e] + ngt[e] * wg[2][e] + bg[e]; const float b = pvl[e] * wv[0][e] + cvl[e] * wv[1][e] + nvl[e] * wv[2][e] + bv[e];
                    o[e] = pg8::silu_f(a) * b; pgt[e] = cgt[e]; pvl[e] = cvl[e]; cgt[e] = ngt[e]; cvl[e] = nvl[e]; }
                u32x4 w; w.x = pg8::cvt_pk_bf16(o[0], o[1]); w.y = pg8::cvt_pk_bf16(o[2], o[3]); w.z = pg8::cvt_pk_bf16(o[4], o[5]); w.w = pg8::cvt_pk_bf16(o[6], o[7]);
                *(u32x4*)(HB + (size_t)(r0 + rr + j) * PITCH + cg0) = w;
            }
        }
    }
}

__device__ __forceinline__ void ph_final(const Params& P, int bid, int G, int tid) {
    asm volatile("" : "+v"(tid)); asm volatile("" : "+s"(bid)); asm volatile("" : "+s"(G));
    const int lane = tid & 63, wave = tid >> 6; const f32x4* gp = (const f32x4*)inp(P, I_FING) + lane;
    const int NGW = G * NWAVES;
    f32x4 gv[4];
#pragma unroll
    for (int j = 0; j < 4; ++j) gv[j] = gp[64 * j];
    for (int row = bid * NWAVES + wave; row < 2 * GT; row += 2 * NGW) {
        const int row2 = row + NGW; const bool has2 = row2 < 2 * GT;
        f32x4* xr = (f32x4*)(P.out + (size_t)row * DMODEL) + lane; f32x4* xr2 = (f32x4*)(P.out + (size_t)(has2 ? row2 : row) * DMODEL) + lane;
        f32x4 v[4], v2[4]; float s = 0.f, s2 = 0.f;
#pragma unroll
        for (int j = 0; j < 4; ++j) { v[j] = xr[64 * j]; v2[j] = xr2[64 * j]; }
#pragma unroll
        for (int j = 0; j < 4; ++j) { s += (v[j].x * v[j].x + v[j].y * v[j].y) + (v[j].z * v[j].z + v[j].w * v[j].w); s2 += (v2[j].x * v2[j].x + v2[j].y * v2[j].y) + (v2[j].z * v2[j].z + v2[j].w * v2[j].w); }
        const float rs = rsqrtf(wave_sum(s) * (1.0f / 1024.0f) + EPSN), rs2 = rsqrtf(wave_sum(s2) * (1.0f / 1024.0f) + EPSN);
#pragma unroll
        for (int j = 0; j < 4; ++j) xr[64 * j] = v[j] * rs * gv[j];
        if (has2) {
#pragma unroll
            for (int j = 0; j < 4; ++j) xr2[64 * j] = v2[j] * rs2 * gv[j];
        }
    }
}

#define XB_TMO      128
#define XB_XCNT(j)  (256  + 64 * (j))
#define XB_XSUB(j)  (1280 + 64 * (j))
#define XB_XGEN(j)  (2304 + 64 * (j))
#define XB_TOP      3328
#define XB_TOPGEN   3392
#define XCD_BAR_WORDS 3456
#define XB_SPIN_CAP (1u << 22)
__device__ __forceinline__ unsigned xb_ld(unsigned* p)              { return __hip_atomic_load(p, __ATOMIC_RELAXED, __HIP_MEMORY_SCOPE_AGENT); }
__device__ __forceinline__ unsigned xb_add(unsigned* p, unsigned v) { return __hip_atomic_fetch_add(p, v, __ATOMIC_RELAXED, __HIP_MEMORY_SCOPE_AGENT); }
__device__ __forceinline__ unsigned xb_xcc_id() { return (unsigned)__builtin_amdgcn_s_getreg((3 << 11) | 20) & 0xFu; }
#define XB_SPIN(cond, bar) do { unsigned _sp = 0; while (cond) { __builtin_amdgcn_s_sleep(1); \
    if ((++_sp & 255u) == 0u) { if (xb_ld(&(bar)[XB_TMO])) break; if (_sp > XB_SPIN_CAP) { atomicAdd(&(bar)[XB_TMO], 1u); break; } } } } while (0)
__device__ __forceinline__ void xcd_barrier_complete(unsigned* bar, unsigned x, unsigned G, unsigned& nloc, unsigned& nx) {
    unsigned sum, cnt, mine, sp = 0u;
    for (;;) {
        sum = 0u; cnt = 0u; mine = 0u;
#pragma unroll
        for (unsigned j = 0; j < 16; ++j) { const unsigned c = xb_ld(&bar[XB_XCNT(j)]); sum += c; cnt += (c > 0u) ? 1u : 0u; mine = (j == x) ? c : mine; }
        if (sum == G) break;
        __builtin_amdgcn_s_sleep(1);
        if ((++sp & 255u) == 0u) { if (xb_ld(&bar[XB_TMO])) break; if (sp > XB_SPIN_CAP) { atomicAdd(&bar[XB_TMO], 1u); break; } }
    }
    nloc = mine > 0u ? mine : 1u; nx = cnt > 0u ? cnt : 1u;
}
__device__ __forceinline__ void grid_bar(unsigned* bar, volatile LAS unsigned* st, unsigned G, int tid) {
    asm volatile("s_waitcnt vmcnt(0) lgkmcnt(0)" ::: "memory");
    __syncthreads();
    if (tid == 0) {
        const unsigned x = xb_xcc_id();
        __builtin_amdgcn_s_waitcnt(0);
        unsigned nloc = st[0], nx = st[1];
        if (nloc == 0u) { xcd_barrier_complete(bar, x, G, nloc, nx); st[0] = nloc; st[1] = nx; }
        const unsigned old = xb_add(&bar[XB_XSUB(x)], 1u);
        const unsigned gen = old / nloc;
        if (old + 1u == (gen + 1u) * nloc) {
            __builtin_amdgcn_fence(__ATOMIC_RELEASE, "agent");
            asm volatile("s_waitcnt vmcnt(0)" ::: "memory");
            const unsigned og = xb_add(&bar[XB_TOP], 1u);
            const unsigned tg = og / nx;
            if (og + 1u == (tg + 1u) * nx) xb_add(&bar[XB_TOPGEN], 1u);
            else XB_SPIN(xb_ld(&bar[XB_TOPGEN]) == tg, bar);
            __builtin_amdgcn_fence(__ATOMIC_ACQUIRE, "agent");
            xb_add(&bar[XB_XGEN(x)], 1u);
            asm volatile("s_waitcnt vmcnt(0)" ::: "memory");
        } else {
            XB_SPIN(xb_ld(&bar[XB_XGEN(x)]) == gen, bar);
            __builtin_amdgcn_fence(__ATOMIC_ACQUIRE, "agent");
            asm volatile("s_waitcnt vmcnt(0)" ::: "memory");
        }
    }
    __syncthreads();
}
constexpr int BARST_OFF = LDS_BYTES - 64;
#define PH_BEGIN(I) { int lo = P.lo, hi = P.hi; asm volatile("" : "+v"(lo)); asm volatile("" : "+v"(hi));   if ((I) >= lo && (I) < hi) { \
        int tid = wave_s * 64 + (int)__builtin_amdgcn_mbcnt_hi(~0u, __builtin_amdgcn_mbcnt_lo(~0u, 0u)); asm volatile("" : "+v"(tid)); \
        unsigned char* ws = P.ws; asm volatile("" : "+s"(ws)); int G = gridDim.x; asm volatile("" : "+s"(G)); int bid = blockIdx.x; asm volatile("" : "+s"(bid)); \
        if ((I) > lo) grid_bar((unsigned*)(ws + WS_BAR), (volatile LAS unsigned*)(lds + BARST_OFF), (unsigned)G, tid); \
        bf16_t* HB = (bf16_t*)(ws + WS_HB); bf16_t* XB = (bf16_t*)(ws + WS_XB); float* ssq1 = (float*)(ws + WS_SSQ1); float* ssq2 = (float*)(ws + WS_SSQ2); (void)HB; (void)XB; (void)ssq1; (void)ssq2; (void)tid; (void)G; (void)bid;
#define PH_END } }
#define BAR2(k) grid_bar((unsigned*)(ws + WS_BAR), (volatile LAS unsigned*)(lds + BARST_OFF), (unsigned)G, tid)
template <int MASK, int L, int GR> __device__ __forceinline__ void run_lg(const Params& P, const int wave_s, unsigned char* lds_raw, LAS unsigned char* lds) {
    constexpr int I0 = L * 16 + GR * 8;
    PH_BEGIN(I0 + 0) { const float* xsrc = L == 0 ? inp(P, GR) : (const float*)(P.out + (size_t)GR * GT * DMODEL);
        if (GR == 0 && PHON(9)) ph_wprep(P, bid, G, ws, L, lds, tid);
        if (PHON(0)) ph_p1(bid, G, ws, xsrc, tid); } PH_END
    PH_BEGIN(I0 + 1) if (PHON(1)) {
        pg8::Gemm gm{XB, (const bf16_t*)(ws + WS_W1), 1024, 1024, 1024}; pg8::Order S; S.init(GT, 5632, G, bid, 1, 0);
        pg8::Epi1 E{(pg8::gbf_p)HB, (pg8::gf_cp)ssq1, (pg8::gf_cp)(inp(P, I_BGATE) + L * 3072)};
        pg8::gemm_phase<pg8::Epi1, pg8::Order, true, true>(lds, gm, S, E, tid);
        if (PROBE == 2) { __syncthreads(); pg8::gemm_phase<pg8::Epi1, pg8::Order, true, true>(lds, gm, S, E, tid); } } PH_END
    PH_BEGIN(I0 + 2) if (PHON(2)) { ph_p3a(P, bid, G, ws, L, GR, lds, tid);
        if (PROBE == 6 || PROBE == 10 || PROBE == 11) { constexpr int Q = (L * 2 + GR) * 2; if (PROBE != 6) { BAR2(0); ph_p3a(P, bid, G, ws, L, GR, lds, tid, PROBE == 10 ? 1 : 2); } BAR2(Q + 1); { pg8::Gemm gm{XB, (const bf16_t*)(ws + WS_W1), 1024, 1024, 1024}; pg8::Order S; S.init(GT, 5632, G, bid, 1, 0); pg8::Epi1 E{(pg8::gbf_p)HB, (pg8::gf_cp)ssq1, (pg8::gf_cp)(inp(P, I_BGATE) + L * 3072)}; pg8::gemm_phase<pg8::Epi1, pg8::Order, true, true>(lds, gm, S, E, tid); } BAR2(Q + 2); ph_p3a(P, bid, G, ws, L, GR, lds, tid); } } PH_END
    PH_BEGIN(I0 + 3) if (PHON(3)) {
        if (PROBE == 12 || PROBE == 13) { ph_p3b(P, bid, G, ws, L, GR, lds_raw, lds, tid, PROBE == 12 ? 1 : 2); BAR2(0); { pg8::Gemm gm{XB, (const bf16_t*)(ws + WS_W1), 1024, 1024, 1024}; pg8::Order S; S.init(GT, 5632, G, bid, 1, 0); pg8::Epi1 E{(pg8::gbf_p)HB, (pg8::gf_cp)ssq1, (pg8::gf_cp)(inp(P, I_BGATE) + L * 3072)}; pg8::gemm_phase<pg8::Epi1, pg8::Order, true, true>(lds, gm, S, E, tid); } BAR2(0); ph_p3a(P, bid, G, ws, L, GR, lds, tid); BAR2(0); }
        ph_p3b(P, bid, G, ws, L, GR, lds_raw, lds, tid); } PH_END
    PH_BEGIN(I0 + 4) if (PHON(4)) {
        pg8::Gemm gm{HB, (const bf16_t*)(ws + WS_WB), PITCH, 1536, 512}; pg8::Order S; S.init(GT, 1024, G, bid, 3, 512);
        pg8::Epi4 E{(pg8::gbf_p)HB};
        pg8::gemm_phase<pg8::Epi4, pg8::Order, true, true>(lds, gm, S, E, tid);
        if (PROBE == 4) { __syncthreads(); pg8::gemm_phase<pg8::Epi4, pg8::Order, true, true>(lds, gm, S, E, tid); } } PH_END
    PH_BEGIN(I0 + 5) if (PHON(5)) {
        float* xdst = P.out + (size_t)GR * GT * DMODEL; const float* xsrc = L == 0 ? inp(P, GR) : (const float*)xdst;
        pg8::Gemm gm{HB + COL_MERGED, (const bf16_t*)(ws + WS_WO), PITCH, 1024, 1024}; pg8::Order S; S.init(GT, 1024, G, bid, 1, 0);
        pg8::Epi5 E{(pg8::gf_cp)xsrc, (pg8::gf_p)xdst, (pg8::gbf_p)XB, (pg8::gf_p)ssq2};
        pg8::gemm_phase<pg8::Epi5, pg8::Order, true, true>(lds, gm, S, E, tid); } PH_END
    PH_BEGIN(I0 + 6) if (PHON(6)) {
        pg8::Gemm gm{XB, (const bf16_t*)(ws + WS_WU), 1024, 1024, 1024}; pg8::Order S; S.init_ovl(65, 5632, G, bid);
        pg8::Epi7f E{(pg8::gbf_p)HB, (pg8::gf_cp)ssq2, (pg8::gf_cp)(inp(P, I_CW) + (size_t)L * 3 * 5632), (pg8::gf_cp)(inp(P, I_CB) + (size_t)L * 5632), (PG8_LAS float*)(lds + 131072), (GR == 0 ? 2048 : 4096) - 1, GT};
        pg8::gemm_phase<pg8::Epi7f, pg8::Order, true, true>(lds, gm, S, E, tid); } PH_END
    PH_BEGIN(I0 + 7) if (PHON(5)) {
        float* xdst = P.out + (size_t)GR * GT * DMODEL;
        pg8::Gemm gm{HB, (const bf16_t*)(ws + WS_WD), PITCH, 2816, 2816}; pg8::Order S; S.init(GT, 1024, G, bid, 1, 0);
        pg8::Epi5 E{(pg8::gf_cp)xdst, (pg8::gf_p)xdst, (pg8::gbf_p)nullptr, (pg8::gf_p)nullptr};
        pg8::gemm_phase<pg8::Epi5, pg8::Order, true, true>(lds, gm, S, E, tid); } PH_END
}
template <int MASK> __device__ __forceinline__ void fwd_body(const Params& P) {
    extern __shared__ __attribute__((aligned(16))) unsigned char lds_raw[];
    LAS unsigned char* lds = (LAS unsigned char*)lds_raw;
    const int wave_s = __builtin_amdgcn_readfirstlane((int)threadIdx.x >> 6);
    { if (threadIdx.x == 0) { ((volatile LAS unsigned*)(lds + BARST_OFF))[0] = 0u; ((volatile LAS unsigned*)(lds + BARST_OFF))[1] = 0u; (void)xb_add((unsigned*)(P.ws + WS_BAR) + XB_XCNT(xb_xcc_id()), 1u); } __syncthreads(); }
    if (P.hi < 0) { cg::grid_group grid = cg::this_grid(); grid.sync(); }
    run_lg<MASK, 0, 0>(P, wave_s, lds_raw, lds);
    run_lg<MASK, 0, 1>(P, wave_s, lds_raw, lds);
    run_lg<MASK, 1, 0>(P, wave_s, lds_raw, lds);
    run_lg<MASK, 1, 1>(P, wave_s, lds_raw, lds);
    PH_BEGIN(NPH - 1) if (PHON(10)) ph_final(P, bid, G, tid); PH_END
}

#if MK_MULTI
#define DEFK(name, mask) __global__ void __launch_bounds__(NTHR, 2) name(Params P) { fwd_body<mask>(P); }
DEFK(fwd_k0, 0x001) DEFK(fwd_k1, 0x002) DEFK(fwd_k2, 0x004) DEFK(fwd_k3, 0x008) DEFK(fwd_k4, 0x010) DEFK(fwd_k5, 0x020) DEFK(fwd_k6, 0x040) DEFK(fwd_k7, 0x080) DEFK(fwd_k9, 0x200) DEFK(fwd_k10, 0x400)
#define fwd_kernel fwd_k3
#else
__global__ void __launch_bounds__(NTHR, 2) fwd_kernel(Params P) { fwd_body<PH_MASK>(P); }
#endif

extern "C" void kernel_launch(void* const* d_in, const int* in_sizes, int n_in, void* d_out, int out_size, void* d_ws, size_t ws_size, hipStream_t stream) {
    static int grid = 0;
    if (grid == 0) {
        if (n_in != 22 || out_size != 2 * GT * DMODEL || ws_size < WS_END) { fprintf(stderr, "kernel_launch: unexpected shapes (n_in %d out %d ws %zu)\n", n_in, out_size, ws_size); grid = -1; return; }
        int dev = 0, cus = 0, per_cu = 0;
        if (hipGetDevice(&dev) != hipSuccess || hipDeviceGetAttribute(&cus, hipDeviceAttributeMultiprocessorCount, dev) != hipSuccess) { grid = -1; return; }
        if (hipFuncSetAttribute((const void*)fwd_kernel, hipFuncAttributeMaxDynamicSharedMemorySize, LDS_BYTES) != hipSuccess) { fprintf(stderr, "kernel_launch: hipFuncSetAttribute failed\n"); grid = -1; return; }
        if (hipOccupancyMaxActiveBlocksPerMultiprocessor(&per_cu, (const void*)fwd_kernel, NTHR, LDS_BYTES) != hipSuccess || per_cu < 1) { fprintf(stderr, "kernel_launch: occupancy query says %d\n", per_cu); per_cu = 1; }
        (void)hipGetLastError();
        grid = cus;
    }
    if (grid < 0) return;
    (void)hipMemsetAsync((unsigned char*)d_ws + WS_BAR, 0, 16384, stream);
    Params p{};
    for (int i = 0; i < 22; ++i) p.in[i] = (const float*)d_in[i];
    p.out = (float*)d_out; p.ws = (unsigned char*)d_ws;
#if MK_MULTI
    typedef void (*kfn)(Params);
    const kfn kf[11] = {fwd_k0, fwd_k1, fwd_k2, fwd_k3, fwd_k4, fwd_k5, fwd_k6, fwd_k5, fwd_k5, fwd_k9, fwd_k10};
    for (int i = 0; i < 11; ++i) (void)hipFuncSetAttribute((const void*)kf[i], hipFuncAttributeMaxDynamicSharedMemorySize, LDS_BYTES);
    for (int i = 0; i < NPH; ++i) { p.lo = i; p.hi = i + 1;
        const int r = i % 17; const int k = (i == NPH - 1) ? 10 : (r == 0 ? 9 : (r - 1) % 8);
        hipLaunchKernelGGL(kf[k], dim3(grid), dim3(NTHR), LDS_BYTES, stream, p);
        if (PROBE == 8 && k == 3) { for (int d = 2; d >= 0; --d) { p.lo = i - d; p.hi = i - d + 1; hipLaunchKernelGGL(kf[k - d], dim3(grid), dim3(NTHR), LDS_BYTES, stream, p); } } }
#else
    p.lo = 0; p.hi = NPH;
    void* args[] = {&p};
    hipError_t e = hipLaunchCooperativeKernel((const void*)fwd_kernel, dim3(grid), dim3(NTHR), args, LDS_BYTES, stream);
    if (e != hipSuccess) fprintf(stderr, "cooperative launch failed: %s (grid %d)\n", hipGetErrorString(e), grid);
#endif
}
```

```cpp
#include <hip/hip_runtime.h>
#include <hip/hip_cooperative_groups.h>
#include <hip/hip_bf16.h>
#include <cstdio>
#include <cstdint>
#include <cmath>
namespace cg = cooperative_groups;

constexpr int DMODEL = 1024, GT = 16384  , PITCH = 5632  , DFF = 2816;
constexpr int COL_U = 0, COL_QB = 512, COL_QC = 1024, COL_VA = 1536, COL_KB = 2048, COL_VB = 2176, COL_KC = 2304, COL_VC = 2432, COL_MERGED = 1536, COL_GATE = 2560;
constexpr float EPSN = 1e-6f;
constexpr float QK_C2 = 0.125f * 1.4426950408889634f;
__device__ __forceinline__ int otid() { int t = threadIdx.x; asm volatile("" : "+v"(t)); return t; }
__device__ __forceinline__ int obid() { int t = blockIdx.x; asm volatile("" : "+s"(t)); return t; }
__device__ __forceinline__ int ogdim() { int t = gridDim.x; asm volatile("" : "+s"(t)); return t; }

namespace pg8 {
#define PG8_LAS __attribute__((address_space(3)))
typedef unsigned short bf16_t;
typedef short bf16x8 __attribute__((ext_vector_type(8)));
typedef float f32x4 __attribute__((ext_vector_type(4)));
typedef unsigned u32x4 __attribute__((ext_vector_type(4)));
constexpr int BM = 256, BK = 64, HALF = 128, HTB = HALF * BK * 2  , STAGE_BYTES = 8 * HTB, NXCD = 8, WGM = 8;

__host__ __device__ __forceinline__ int lds_byte(int r, int c) { const int st = (r >> 4) * 2 + (c >> 5), rr = r & 15, cc = c & 31, ob = rr * 64 + cc * 2; return st * 1024 + (ob ^ (((ob >> 9) & 1) << 5)); }
__host__ __device__ __forceinline__ void stage_rc(int b, int& R, int& C) { const int st = b / 1024, sb = b % 1024, swz = sb ^ (((sb >> 9) & 1) << 5); R = (st >> 1) * 16 + swz / 64; C = (st & 1) * 32 + (swz % 64) / 2; }
__host__ __device__ __forceinline__ int perm32(int rho) { const int n = rho >> 4, i = rho & 15; return 8 * (i >> 2) + 4 * n + (i & 3); }

struct Unit { int pm, pn, ko, n, arow; };
struct Gemm { const bf16_t* A; const bf16_t* Bt; int lda, ldb, K; };


struct Order {
    int nM, nN, nwg, G, c, rep, kstep, ovl;
    __device__ void init(int M, int N, int G_, int c_, int rep_, int kstep_) { nM = M / BM; nN = N / BM; nwg = nM * nN; G = G_; c = c_; rep = rep_; kstep = kstep_; ovl = 0; }
    __device__ void init_ovl(int nM_, int N, int G_, int c_) { nM = nM_; nN = N / BM; nwg = nM * nN; G = G_; c = c_; rep = 1; kstep = 0; ovl = 1; }
    __device__ bool next(int i, Unit& u) const {
        int ti = i, n = 0; if (rep == 3) { ti = i / 3; n = i - ti * 3; }
        const long L = (long)ti * G + c; if (L >= nwg) return false;
        int wgid = (int)L; { const int q = nwg / NXCD, r = nwg % NXCD, xcd = wgid % NXCD, off = wgid / NXCD; wgid = (xcd < r ? xcd * (q + 1) : r * (q + 1) + (xcd - r) * q) + off; }
        const int nig = WGM * nN, gid = wgid / nig, fm = gid * WGM, gsz = (nM - fm) < WGM ? (nM - fm) : WGM;
        u.pm = fm + ((wgid % nig) % gsz); u.pn = (wgid % nig) / gsz; u.ko = n * kstep; u.n = n; u.arow = ovl ? (u.pm ? 254 * u.pm - 1 : 0) : u.pm * BM; return true;
    }
    __device__ __forceinline__ void a_ready(const Unit&) const {}
    __device__ __forceinline__ void done(const Unit&) const {}
};

__device__ __forceinline__ unsigned cvt_pk_bf16(float lo, float hi) { unsigned r; asm volatile("v_cvt_pk_bf16_f32 %0, %1, %2" : "=v"(r) : "v"(lo), "v"(hi)); return r; }
__device__ __forceinline__ float bf_lo(unsigned w) { return __uint_as_float(w << 16); }
__device__ __forceinline__ float bf_hi(unsigned w) { return __uint_as_float(w & 0xffff0000u); }
__device__ __forceinline__ float sigmoid_f(float v) { return __builtin_amdgcn_rcpf(1.0f + __builtin_amdgcn_exp2f(-1.4426950408889634f * v)); }
__device__ __forceinline__ float gelu_tanh_f(float v) { const float t = v * (1.0f + 0.044715f * v * v); return v * __builtin_amdgcn_rcpf(1.0f + __builtin_amdgcn_exp2f(-2.3022082008f * t)); }
__device__ __forceinline__ float silu_f(float v) { return v * sigmoid_f(v); }
__device__ __forceinline__ u32x4 pack8(f32x4 a, f32x4 b) { u32x4 w; w.x = cvt_pk_bf16(a[0], a[1]); w.y = cvt_pk_bf16(a[2], a[3]); w.z = cvt_pk_bf16(b[0], b[1]); w.w = cvt_pk_bf16(b[2], b[3]); return w; }

struct Epi1 {
    static constexpr bool PERM = true, AFTER_DRAIN = false;
    bf16_t* O; const float* ssq; const float* bgate; const float* qg; const float* kg; PG8_LAS float* xl; const PG8_LAS float* tab; int smask;
    __device__ __forceinline__ void rope_path(const f32x4 (&acc)[2][2][4][2], const Unit& u, int wr, int wc, int fr, int fq, const bool isq) const {
        const int lrow0 = wr * 64 + fr, col0 = u.pn * BM + wc * 32 + 8 * fq;
        float sq[2][4];
#pragma unroll
        for (int ai = 0; ai < 2; ++ai)
#pragma unroll
            for (int m = 0; m < 4; ++m) sq[ai][m] = ssq[u.pm * BM + lrow0 + ai * HALF + m * 16];
        const float* gsrc = (isq ? qg : kg) + 32 * (wc & 1) + 8 * fq;
        const f32x4 g0 = *(const f32x4*)gsrc, g1 = *(const f32x4*)(gsrc + 4);
        const float sc = isq ? QK_C2 : 1.0f;
#pragma unroll
        for (int ai = 0; ai < 2; ++ai)
#pragma unroll
            for (int m = 0; m < 4; ++m) { const float rs2 = 1.0f / (sq[ai][m] * (1.0f / 1024.0f) + EPSN);
#pragma unroll
                for (int bj = 0; bj < 2; ++bj) { if (!isq && bj == 1) continue;
                    const f32x4 a = acc[ai][bj][m][0], b = acc[ai][bj][m][1];
                    float s = ((a[0] * a[0] + a[1] * a[1]) + (a[2] * a[2] + a[3] * a[3])) + ((b[0] * b[0] + b[1] * b[1]) + (b[2] * b[2] + b[3] * b[3]));
                    s += __shfl_xor(s, 16); s += __shfl_xor(s, 32);
                    if (fq == 0) xl[((lrow0 + ai * HALF + m * 16) * 2 + bj) * 4 + wc] = s * rs2; } }
        asm volatile("s_waitcnt lgkmcnt(0)" ::: "memory"); __builtin_amdgcn_s_barrier(); asm volatile("" ::: "memory");
#pragma unroll
        for (int ai = 0; ai < 2; ++ai)
#pragma unroll
            for (int m = 0; m < 4; ++m) {
                const int lrow = lrow0 + ai * HALF + m * 16, grow = u.pm * BM + lrow, t = grow & smask, pos = (wc & 1) ? (t & 63) : (t >> 6);
                const float rs = rsqrtf(sq[ai][m] * (1.0f / 1024.0f) + EPSN);
                const PG8_LAS float* tp = tab + (pos * 16 + 8 * (fq & 1)) * 2;
                const f32x4 c0 = *(const PG8_LAS f32x4*)tp, c1 = *(const PG8_LAS f32x4*)(tp + 4), c2 = *(const PG8_LAS f32x4*)(tp + 8), c3 = *(const PG8_LAS f32x4*)(tp + 12);
                bf16_t* rowp = O + (size_t)grow * PITCH + col0;
#pragma unroll
                for (int bj = 0; bj < 2; ++bj) {
                    if (!isq && bj == 1) { *(u32x4*)(rowp + HALF) = pack8(acc[ai][1][m][0] * rs, acc[ai][1][m][1] * rs); continue; }
                    const PG8_LAS float* xp = xl + ((lrow * 2 + bj) * 4 + (wc & 2));
                    const float hr = rsqrtf((xp[0] + xp[1]) * (1.0f / 64.0f) + EPSN) * rs * sc;
                    f32x4 o0, o1;
#pragma unroll
                    for (int k = 0; k < 8; ++k) {
                        const float y = (k < 4 ? acc[ai][bj][m][0][k & 3] * g0[k & 3] : acc[ai][bj][m][1][k & 3] * g1[k & 3]) * hr;
                        const auto rr = __builtin_amdgcn_permlane32_swap(__float_as_uint(y), __float_as_uint(y), false, false);
                        const float partner = __uint_as_float(fq < 2 ? rr[1] : rr[0]);
                        const f32x4 cs = (k >> 1) == 0 ? c0 : (k >> 1) == 1 ? c1 : (k >> 1) == 2 ? c2 : c3;
                        const float cv = cs[(k & 1) * 2], sv = cs[(k & 1) * 2 + 1];
                        const float r = y * cv + (fq < 2 ? -partner : partner) * sv;
                        if (k < 4) o0[k & 3] = r; else o1[k & 3] = r; }
                    *(u32x4*)(rowp + bj * HALF) = pack8(o0, o1);
                }
            }
    }
    __device__ __forceinline__ void operator()(const f32x4 (&acc)[2][2][4][2], const Unit& u, int wr, int wc, int fr, int fq) const {
        const int row0 = u.pm * BM + wr * 64 + fr, col0 = u.pn * BM + wc * 32 + 8 * fq, pn = u.pn;
        if (pn == 4 || pn == 5 || pn == 9) { rope_path(acc, u, wr, wc, fr, fq, pn != 9); return; }
        const int mode = (pn >= 10) ? 3 : ((pn < 2 || pn == 6 || pn == 7) ? 1 : ((pn == 2 || pn == 3) ? 2 : 0));
        f32x4 bv[2][2];
#pragma unroll
        for (int bj = 0; bj < 2; ++bj)
#pragma unroll
            for (int n = 0; n < 2; ++n) bv[bj][n] = (mode == 3) ? *(const f32x4*)(bgate + (col0 - COL_GATE) + bj * HALF + 4 * n) : (f32x4){0.f, 0.f, 0.f, 0.f};
        float sq[2][4];
#pragma unroll
        for (int ai = 0; ai < 2; ++ai)
#pragma unroll
            for (int m = 0; m < 4; ++m) sq[ai][m] = ssq[row0 + ai * HALF + m * 16];
#pragma unroll
        for (int ai = 0; ai < 2; ++ai)
#pragma unroll
            for (int m = 0; m < 4; ++m) {
                const int row = row0 + ai * HALF + m * 16; const float rs = rsqrtf(sq[ai][m] * (1.0f / 1024.0f) + EPSN);
                bf16_t* rowp = O + (size_t)row * PITCH + col0;
#pragma unroll
                for (int bj = 0; bj < 2; ++bj) {
                    f32x4 v0 = acc[ai][bj][m][0] * rs, v1 = acc[ai][bj][m][1] * rs;
                    if (mode == 1) {
#pragma unroll
                        for (int e = 0; e < 4; ++e) { v0[e] = gelu_tanh_f(v0[e]); v1[e] = gelu_tanh_f(v1[e]); }
                    } else if (mode == 2) { v0 = v0 * QK_C2; v1 = v1 * QK_C2; }
                    else if (mode == 3) { v0 = v0 + bv[bj][0]; v1 = v1 + bv[bj][1];
#pragma unroll
                        for (int e = 0; e < 4; ++e) { v0[e] = sigmoid_f(v0[e]); v1[e] = sigmoid_f(v1[e]); } }
                    *(u32x4*)(rowp + bj * HALF) = pack8(v0, v1);
                }
            }
    }
};

struct Epi4 {
    static constexpr bool PERM = true, AFTER_DRAIN = false;
    bf16_t* HB;
    __device__ __forceinline__ void operator()(const f32x4 (&acc)[2][2][4][2], const Unit& u, int wr, int wc, int fr, int fq) const {
        const int row0 = u.pm * BM + wr * 64 + fr, col0 = u.pn * BM + wc * 32 + 8 * fq;
#pragma unroll
        for (int ai = 0; ai < 2; ++ai) {
            u32x4 gw[4][2], mw[4][2];
#pragma unroll
            for (int m = 0; m < 4; ++m) { const bf16_t* gp = HB + (size_t)(row0 + ai * HALF + m * 16) * PITCH + COL_GATE + u.n * 1024 + col0;
#pragma unroll
                for (int bj = 0; bj < 2; ++bj) gw[m][bj] = *(const u32x4*)(gp + bj * HALF); }
            if (u.n > 0) {
#pragma unroll
                for (int m = 0; m < 4; ++m) { const bf16_t* mp = HB + (size_t)(row0 + ai * HALF + m * 16) * PITCH + COL_MERGED + col0;
#pragma unroll
                    for (int bj = 0; bj < 2; ++bj) mw[m][bj] = *(const u32x4*)(mp + bj * HALF); }
            } else {
#pragma unroll
                for (int m = 0; m < 4; ++m)
#pragma unroll
                    for (int bj = 0; bj < 2; ++bj) mw[m][bj] = (u32x4){0u, 0u, 0u, 0u};
            }
#pragma unroll
            for (int m = 0; m < 4; ++m) { bf16_t* mp = HB + (size_t)(row0 + ai * HALF + m * 16) * PITCH + COL_MERGED + col0;
#pragma unroll
                for (int bj = 0; bj < 2; ++bj) { const u32x4 g = gw[m][bj], w = mw[m][bj];
                    const f32x4 v0 = acc[ai][bj][m][0] * (f32x4){bf_lo(g.x), bf_hi(g.x), bf_lo(g.y), bf_hi(g.y)} + (f32x4){bf_lo(w.x), bf_hi(w.x), bf_lo(w.y), bf_hi(w.y)};
                    const f32x4 v1 = acc[ai][bj][m][1] * (f32x4){bf_lo(g.z), bf_hi(g.z), bf_lo(g.w), bf_hi(g.w)} + (f32x4){bf_lo(w.z), bf_hi(w.z), bf_lo(w.w), bf_hi(w.w)};
                    *(u32x4*)(mp + bj * HALF) = pack8(v0, v1); } }
        }
    }
};

struct Epi5 {
    static constexpr bool PERM = false, AFTER_DRAIN = false;
    const float* xin; float* xout; bf16_t* xb; float* ssq;
    __device__ __forceinline__ void operator()(const f32x4 (&acc)[2][2][4][2], const Unit& u, int wr, int wc, int fr, int fq) const {
        typedef unsigned u32x2v __attribute__((ext_vector_type(2)));
        const int row0 = u.pm * BM + wr * 64 + fr, col0 = u.pn * BM + wc * 32 + 4 * fq;
#pragma unroll
        for (int ai = 0; ai < 2; ++ai) {
            f32x4 xv[4][2][2];
#pragma unroll
            for (int m = 0; m < 4; ++m) { const size_t off = (size_t)(row0 + ai * HALF + m * 16) * DMODEL + col0;
#pragma unroll
                for (int bj = 0; bj < 2; ++bj)
#pragma unroll
                    for (int n = 0; n < 2; ++n) xv[m][bj][n] = *(const f32x4*)(xin + off + bj * HALF + n * 16); }
#pragma unroll
            for (int m = 0; m < 4; ++m) {
                const int row = row0 + ai * HALF + m * 16; const size_t off = (size_t)row * DMODEL + col0; float s = 0.f;
#pragma unroll
                for (int bj = 0; bj < 2; ++bj)
#pragma unroll
                    for (int n = 0; n < 2; ++n) { const size_t c = off + bj * HALF + n * 16; const f32x4 xn = xv[m][bj][n] + acc[ai][bj][m][n]; *(f32x4*)(xout + c) = xn;
                        if (xb) { u32x2v w; w.x = cvt_pk_bf16(xn[0], xn[1]); w.y = cvt_pk_bf16(xn[2], xn[3]); *(u32x2v*)(xb + c) = w; }
                        s += (xn[0] * xn[0] + xn[1] * xn[1]) + (xn[2] * xn[2] + xn[3] * xn[3]); }
                if (ssq) { s += __shfl_xor(s, 16); s += __shfl_xor(s, 32); if (fq == 0) atomicAdd(ssq + row, s); }
            }
        }
    }
};

struct Epi7 {
    static constexpr bool PERM = true, AFTER_DRAIN = false;
    bf16_t* O; const float* ssq; bf16_t* halo;
    __device__ __forceinline__ void operator()(const f32x4 (&acc)[2][2][4][2], const Unit& u, int wr, int wc, int fr, int fq) const {
        const int row0 = u.pm * BM + wr * 64 + fr, col0 = u.pn * BM + wc * 32 + 8 * fq;
#pragma unroll
        for (int ai = 0; ai < 2; ++ai)
#pragma unroll
            for (int m = 0; m < 4; ++m) {
                const int row = row0 + ai * HALF + m * 16; const float rs = rsqrtf(ssq[row] * (1.0f / 1024.0f) + EPSN);
                bf16_t* rowp = O + (size_t)row * PITCH + col0;
                const bool top = (m == 0 && fr == 0), bot = (m == 3 && fr == 15);
                bf16_t* hp = halo + (size_t)((row >> 6) * 2 + (bot ? 1 : 0)) * PITCH + col0;
#pragma unroll
                for (int bj = 0; bj < 2; ++bj) {
                    const u32x4 w = pack8(acc[ai][bj][m][0] * rs, acc[ai][bj][m][1] * rs);
                    *(u32x4*)(rowp + bj * HALF) = w;
                    if (top || bot) *(u32x4*)(hp + bj * HALF) = w;
                }
            }
    }
};

__device__ __forceinline__ float dpp_ror1(float x) { return __int_as_float(__builtin_amdgcn_update_dpp(0, __float_as_int(x), 0x121, 0xf, 0xf, false)); }
__device__ __forceinline__ float dpp_rol1(float x) { return __int_as_float(__builtin_amdgcn_update_dpp(0, __float_as_int(x), 0x12F, 0xf, 0xf, false)); }
struct Epi7f {
    static constexpr bool PERM = true, AFTER_DRAIN = false;
    bf16_t* O; const float* ssq; const float* cw; const float* cb; PG8_LAS float* xl; int smask; int nrows;
    __device__ __forceinline__ void operator()(f32x4 (&acc)[2][2][4][2], const Unit& u, int wr, int wc, int fr, int fq) const {
        typedef unsigned u32x2v __attribute__((ext_vector_type(2)));
        const int lrow0 = wr * 64 + fr, arow = u.arow, olo = u.pm ? 1 : 0;
        float sq[2][4];
#pragma unroll
        for (int ai = 0; ai < 2; ++ai)
#pragma unroll
            for (int m = 0; m < 4; ++m) { int grow = arow + lrow0 + ai * HALF + m * 16; grow = grow < nrows ? grow : nrows - 1; sq[ai][m] = ssq[grow]; }
#pragma unroll
        for (int ai = 0; ai < 2; ++ai)
#pragma unroll
            for (int m = 0; m < 4; ++m) { const float rs = rsqrtf(sq[ai][m] * (1.0f / 1024.0f) + EPSN);
#pragma unroll
                for (int bj = 0; bj < 2; ++bj)
#pragma unroll
                    for (int n = 0; n < 2; ++n) acc[ai][bj][m][n] = acc[ai][bj][m][n] * rs; }
#pragma unroll
        for (int ai = 0; ai < 2; ++ai) { const int blk = 2 * ai + wr;
            if (fr == 15) { PG8_LAS float* p = xl + (((0 * 4 + blk) * 4 + wc) * 4 + fq) * 16;
#pragma unroll
                for (int bj = 0; bj < 2; ++bj)
#pragma unroll
                    for (int n = 0; n < 2; ++n) *(PG8_LAS f32x4*)(p + (bj * 2 + n) * 4) = acc[ai][bj][3][n]; }
            if (fr == 0) { PG8_LAS float* p = xl + (((1 * 4 + blk) * 4 + wc) * 4 + fq) * 16;
#pragma unroll
                for (int bj = 0; bj < 2; ++bj)
#pragma unroll
                    for (int n = 0; n < 2; ++n) *(PG8_LAS f32x4*)(p + (bj * 2 + n) * 4) = acc[ai][bj][0][n]; } }
        asm volatile("s_waitcnt lgkmcnt(0)" ::: "memory"); __builtin_amdgcn_s_barrier(); asm volatile("" ::: "memory");
#pragma unroll
        for (int n = 0; n < 2; ++n) {
            const int cg = u.pn * HALF + wc * 32 + 8 * fq + 4 * n, cv = 2816 + cg;
            const f32x4 wg0 = *(const f32x4*)(cw + cg), wg1 = *(const f32x4*)(cw + 5632 + cg), wg2 = *(const f32x4*)(cw + 2 * 5632 + cg), bg = *(const f32x4*)(cb + cg);
            const f32x4 wv0 = *(const f32x4*)(cw + cv), wv1 = *(const f32x4*)(cw + 5632 + cv), wv2 = *(const f32x4*)(cw + 2 * 5632 + cv), bv = *(const f32x4*)(cb + cv);
#pragma unroll
            for (int ai = 0; ai < 2; ++ai) { const int blk = 2 * ai + wr;
                const PG8_LAS float* pl = xl + (((0 * 4 + (blk > 0 ? blk - 1 : 0)) * 4 + wc) * 4 + fq) * 16;
                const PG8_LAS float* pf = xl + (((1 * 4 + (blk < 3 ? blk + 1 : 3)) * 4 + wc) * 4 + fq) * 16;
#pragma unroll
                for (int m = 0; m < 4; ++m) {
                    const int lrow = lrow0 + ai * HALF + m * 16, grow = arow + lrow;
                    const bool zp = (grow & smask) == 0, zn = ((grow + 1) & smask) == 0;
                    f32x4 hc[2];
#pragma unroll
                    for (int bj = 0; bj < 2; ++bj) {
                        const f32x4 cur = acc[ai][bj][m][n];
                        f32x4 pb, nb;
                        if (m > 0) pb = acc[ai][bj][m - 1][n]; else pb = *(const PG8_LAS f32x4*)(pl + (bj * 2 + n) * 4);
                        if (m < 3) nb = acc[ai][bj][m + 1][n]; else nb = *(const PG8_LAS f32x4*)(pf + (bj * 2 + n) * 4);
                        f32x4 prev, next;
#pragma unroll
                        for (int e = 0; e < 4; ++e) {
                            const float a = dpp_ror1(cur[e]), b = (m > 0) ? dpp_ror1(pb[e]) : pb[e];
                            const float c = dpp_rol1(cur[e]), d = (m < 3) ? dpp_rol1(nb[e]) : nb[e];
                            prev[e] = zp ? 0.f : (fr == 0 ? b : a); next[e] = zn ? 0.f : (fr == 15 ? d : c); }
                        hc[bj] = bj == 0 ? prev * wg0 + cur * wg1 + next * wg2 + bg : prev * wv0 + cur * wv1 + next * wv2 + bv;
                    }
                    if (lrow >= olo && lrow <= olo + 253 && grow < nrows) {
                        u32x2v w; w.x = cvt_pk_bf16(silu_f(hc[0][0]) * hc[1][0], silu_f(hc[0][1]) * hc[1][1]); w.y = cvt_pk_bf16(silu_f(hc[0][2]) * hc[1][2], silu_f(hc[0][3]) * hc[1][3]);
                        *(u32x2v*)(O + (size_t)grow * PITCH + cg) = w; }
                }
            }
        }
    }
};

template <class Epi, class Sched, bool ALIGN_EPI = false, bool SP2 = false>
__device__ __forceinline__ void gemm_phase(PG8_LAS unsigned char* lds, const Gemm g, const Sched& S, const Epi& E, const int tid_in) {
    int tid = tid_in; asm volatile("" : "+v"(tid)); const int wid = __builtin_amdgcn_readfirstlane(tid >> 6), lane = tid & 63, wr = wid >> 2, wc = wid & 3, fr = lane & 15, fq = lane >> 4;
    const int K = g.K, nt = K / BK;
    unsigned voffA[2], voffB[2];
#pragma unroll
    for (int i = 0; i < 2; ++i) { int R, C; stage_rc(tid * 16 + i * 8192, R, C); const int Rb = Epi::PERM ? ((R & ~31) + perm32(R & 31)) : R;
        voffA[i] = (unsigned)(R * g.lda + C) * 2u; voffB[i] = (unsigned)(Rb * g.ldb + C) * 2u; }
    const size_t kstep = (size_t)(BK * 2);
    const size_t hstepA = (size_t)HALF * g.lda * 2, hstepB = (size_t)HALF * g.ldb * 2;
    const size_t tstepB = 2 * hstepB;
    const unsigned ldsw = (unsigned)wid * 1024u;
    const int aoff = lds_byte(wr * 64 + fr, fq * 8), boff = lds_byte(wc * 32 + fr, fq * 8);
#define PG8_SA(b, h) (((b) * 2 + (h)) * HTB)
#define PG8_SB(b, h) ((4 + (b) * 2 + (h)) * HTB)
#define PG8_STAGE(bufoff, gbase, voff) do { _Pragma("unroll") for (int _i = 0; _i < 2; ++_i) \
        __builtin_amdgcn_global_load_lds((const unsigned*)((const char*)(gbase) + (voff)[_i]), (PG8_LAS unsigned*)(lds + (bufoff) + ldsw + _i * 8192), 16, 0, 0); } while (0)
#define PG8_LDA(dst, b, h) do { _Pragma("unroll") for (int m = 0; m < 4; ++m) _Pragma("unroll") for (int k = 0; k < 2; ++k) dst[m][k] = *(const PG8_LAS bf16x8*)(lds + PG8_SA(b, h) + aoff + m * 2048 + k * 1024); } while (0)
#define PG8_LDB(dst, b, h) do { _Pragma("unroll") for (int n = 0; n < 2; ++n) _Pragma("unroll") for (int k = 0; k < 2; ++k) dst[n][k] = *(const PG8_LAS bf16x8*)(lds + PG8_SB(b, h) + boff + n * 2048 + k * 1024); } while (0)
#define PG8_MMA(ai, bj, At, Bt) do { __builtin_amdgcn_s_setprio(1); _Pragma("unroll") for (int m = 0; m < 4; ++m) _Pragma("unroll") for (int n = 0; n < 2; ++n) _Pragma("unroll") for (int k = 0; k < 2; ++k) \
        acc[ai][bj][m][n] = __builtin_amdgcn_mfma_f32_16x16x32_bf16(Bt[n][k], At[m][k], acc[ai][bj][m][n], 0, 0, 0); __builtin_amdgcn_s_setprio(0); } while (0)
#define PG8_WAIT_V(n) asm volatile("s_waitcnt vmcnt(" #n ")" ::: "memory")
#define PG8_WAIT_L(n) asm volatile("s_waitcnt lgkmcnt(" #n ")" ::: "memory")
#define PG8_BAR __builtin_amdgcn_s_barrier()
#define PG8_SCHED __builtin_amdgcn_sched_barrier(0)
    Unit cur, nxt; int ui = 0;
    if (!S.next(0, cur)) return;
    f32x4 acc[2][2][4][2];
#pragma unroll
    for (int a = 0; a < 2; ++a)
#pragma unroll
        for (int b = 0; b < 2; ++b)
#pragma unroll
            for (int m = 0; m < 4; ++m)
#pragma unroll
                for (int n = 0; n < 2; ++n) acc[a][b][m][n] = (f32x4){0.f, 0.f, 0.f, 0.f};
    bf16x8 At[4][2], B0[2][2], B1[2][2];
    const char* cA = (const char*)g.A + (size_t)cur.arow * (size_t)g.lda * 2 + (size_t)cur.ko * 2; const char* cB = (const char*)g.Bt + (size_t)cur.pn * tstepB + (size_t)cur.ko * 2;
    S.a_ready(cur);
    if constexpr (SP2) {
        PG8_STAGE(PG8_SB(0, 0), cB, voffB); PG8_STAGE(PG8_SB(0, 1), cB + hstepB, voffB); PG8_STAGE(PG8_SA(0, 0), cA, voffA); PG8_STAGE(PG8_SA(0, 1), cA + hstepA, voffA);
        if (wr == 1) PG8_BAR;
        PG8_WAIT_V(2); PG8_BAR;
        PG8_STAGE(PG8_SB(1, 0), cB + kstep, voffB); PG8_STAGE(PG8_SA(1, 0), cA + kstep, voffA); PG8_STAGE(PG8_SB(1, 1), cB + hstepB + kstep, voffB);
        PG8_WAIT_V(6); PG8_BAR;
    } else {
        PG8_STAGE(PG8_SB(0, 0), cB, voffB); PG8_STAGE(PG8_SA(0, 0), cA, voffA); PG8_STAGE(PG8_SB(0, 1), cB + hstepB, voffB); PG8_STAGE(PG8_SA(0, 1), cA + hstepA, voffA);
        if (wr == 1) PG8_BAR;
        PG8_WAIT_V(4); PG8_BAR;
        PG8_STAGE(PG8_SB(1, 0), cB + kstep, voffB); PG8_STAGE(PG8_SA(1, 0), cA + kstep, voffA); PG8_STAGE(PG8_SB(1, 1), cB + hstepB + kstep, voffB);
        PG8_WAIT_V(6); PG8_BAR;
    }
    for (;;) {
        const bool has_next = S.next(ui + 1, nxt);
        const char* nA = has_next ? (const char*)g.A + (size_t)nxt.arow * (size_t)g.lda * 2 + (size_t)nxt.ko * 2 : cA; const char* nB = has_next ? (const char*)g.Bt + (size_t)nxt.pn * tstepB + (size_t)nxt.ko * 2 : cB;
        for (int t = 0; t < nt; t += 2) {
            const bool last = (t == nt - 2);
            const char* a1 = cA + (size_t)(t + 1) * kstep;
            const char* a2 = last ? nA : cA + (size_t)(t + 2) * kstep; const char* b2 = last ? nB : cB + (size_t)(t + 2) * kstep;
            const char* a3 = a2 + kstep; const char* b3 = b2 + kstep;
            if (last && has_next) S.a_ready(nxt);
            if constexpr (SP2) {
            PG8_LDB(B0, 0, 0); PG8_LDB(B1, 0, 1); PG8_SCHED; PG8_LDA(At, 0, 0); PG8_STAGE(PG8_SA(1, 1), a1 + hstepA, voffA);
            PG8_WAIT_V(8); PG8_WAIT_L(0); PG8_BAR; PG8_MMA(0, 0, At, B0); PG8_MMA(0, 1, At, B1); PG8_BAR; PG8_SCHED;
            PG8_LDA(At, 0, 1); PG8_STAGE(PG8_SB(0, 0), b2, voffB); PG8_STAGE(PG8_SB(0, 1), b2 + hstepB, voffB); PG8_STAGE(PG8_SA(0, 0), a2, voffA);
            PG8_WAIT_V(8); PG8_WAIT_L(0); PG8_BAR; PG8_MMA(1, 0, At, B0); PG8_MMA(1, 1, At, B1); PG8_BAR; PG8_SCHED;
            PG8_LDB(B0, 1, 0); PG8_LDB(B1, 1, 1); PG8_SCHED; PG8_LDA(At, 1, 0); PG8_STAGE(PG8_SA(0, 1), a2 + hstepA, voffA);
            PG8_WAIT_V(8); PG8_WAIT_L(0); PG8_BAR; PG8_MMA(0, 0, At, B0); PG8_MMA(0, 1, At, B1); PG8_BAR; PG8_SCHED;
            PG8_LDA(At, 1, 1); PG8_STAGE(PG8_SB(1, 0), b3, voffB); PG8_STAGE(PG8_SB(1, 1), b3 + hstepB, voffB); PG8_STAGE(PG8_SA(1, 0), a3, voffA);
            PG8_WAIT_V(8); PG8_WAIT_L(0); PG8_BAR; PG8_MMA(1, 0, At, B0); PG8_MMA(1, 1, At, B1); PG8_BAR; PG8_SCHED;
            } else {
            PG8_LDB(B0, 0, 0); PG8_SCHED; PG8_LDA(At, 0, 0); PG8_STAGE(PG8_SA(1, 1), a1 + hstepA, voffA);
            PG8_WAIT_L(8); PG8_BAR; PG8_WAIT_L(0); PG8_MMA(0, 0, At, B0); PG8_BAR; PG8_SCHED;
            PG8_LDB(B1, 0, 1); PG8_STAGE(PG8_SB(0, 0), b2, voffB);
            PG8_BAR; PG8_WAIT_L(0); PG8_MMA(0, 1, At, B1); PG8_BAR;
            PG8_LDA(At, 0, 1); PG8_STAGE(PG8_SA(0, 0), a2, voffA);
            PG8_BAR; PG8_WAIT_L(0); PG8_MMA(1, 0, At, B0); PG8_BAR; PG8_SCHED;
            PG8_STAGE(PG8_SB(0, 1), b2 + hstepB, voffB);
            PG8_WAIT_V(6); PG8_BAR; PG8_MMA(1, 1, At, B1); PG8_BAR;
            PG8_LDB(B0, 1, 0); PG8_SCHED; PG8_LDA(At, 1, 0); PG8_STAGE(PG8_SA(0, 1), a2 + hstepA, voffA);
            PG8_WAIT_L(8); PG8_BAR; PG8_WAIT_L(0); PG8_MMA(0, 0, At, B0); PG8_BAR; PG8_SCHED;
            PG8_LDB(B1, 1, 1); PG8_STAGE(PG8_SB(1, 0), b3, voffB);
            PG8_BAR; PG8_WAIT_L(0); PG8_MMA(0, 1, At, B1); PG8_BAR;
            PG8_LDA(At, 1, 1); PG8_STAGE(PG8_SA(1, 0), a3, voffA);
            PG8_BAR; PG8_WAIT_L(0); PG8_MMA(1, 0, At, B0); PG8_BAR; PG8_SCHED;
            PG8_STAGE(PG8_SB(1, 1), b3 + hstepB, voffB);
            PG8_WAIT_V(6); PG8_BAR; PG8_MMA(1, 1, At, B1); PG8_BAR;
            }
        }
        if constexpr (ALIGN_EPI) { if (wr == 0) PG8_BAR; }
        if constexpr (!Epi::AFTER_DRAIN) { E(acc, cur, wr, wc, fr, fq); S.done(cur); }
        if (!has_next) break;
#pragma unroll
        for (int a = 0; a < 2; ++a)
#pragma unroll
            for (int b = 0; b < 2; ++b)
#pragma unroll
                for (int m = 0; m < 4; ++m)
#pragma unroll
                    for (int n = 0; n < 2; ++n) acc[a][b][m][n] = (f32x4){0.f, 0.f, 0.f, 0.f};
        cur = nxt; cA = nA; cB = nB; ++ui;
        if constexpr (ALIGN_EPI) { if (wr == 1) PG8_BAR; }
    }
    PG8_WAIT_V(0);
    if constexpr (!ALIGN_EPI) { if (wr == 0) PG8_BAR; }
    PG8_BAR;
    if constexpr (Epi::AFTER_DRAIN) { E.fused(acc, cur, wr, wc, fr, fq, lds, wid, lane); S.done(cur); }
#undef PG8_SA
#undef PG8_SB
#undef PG8_STAGE
#undef PG8_LDA
#undef PG8_LDB
#undef PG8_MMA
#undef PG8_WAIT_V
#undef PG8_WAIT_L
#undef PG8_BAR
#undef PG8_SCHED
}
}
namespace attn_body {
using bf16=__hip_bfloat16;
using bf16x8=__attribute__((ext_vector_type(8)))short;
using s16x4=__attribute__((ext_vector_type(4)))short;
using f32x16=__attribute__((ext_vector_type(16)))float;
using u32x4=__attribute__((ext_vector_type(4)))unsigned;
constexpr int D=64,DM=5632;
constexpr int NW=8,QBLK=32,QB=QBLK*NW,KVBLK=64;
constexpr int ATTN_PITCH=DM, ATTN_UNIT_ROWS=QB;
__device__ __forceinline__ int crow(int r,int hi){return (r&3)+8*(r>>2)+4*hi;}
#define SBAR() __builtin_amdgcn_sched_barrier(0)
__device__ __forceinline__ void cmask(f32x16&p0,f32x16&p1,int jb,int qrel,int hi){
  const float NEG=-INFINITY; int kb=64*jb+4*hi;
  #pragma unroll
  for(int r=0;r<16;++r){int kv=kb+(r&3)+8*(r>>2); if(kv>qrel)p0[r]=NEG; if(kv+32>qrel)p1[r]=NEG;}
}

typedef __attribute__((address_space(3))) const float* lds_fptr;
__device__ __forceinline__ void bmask(f32x16&p0,f32x16&p1,int rel0,lds_fptr tab){
  float bb[16];
  #pragma unroll
  for(int r=0;r<16;++r){ const int rel=rel0+(r&3)+8*(r>>2); bb[r]=tab[min(max(rel+128,0),256)]; }
  __builtin_amdgcn_sched_barrier(0);
  #pragma unroll
  for(int r=0;r<16;++r){ const int rel=rel0+(r&3)+8*(r>>2); p0[r]=((unsigned)(rel+128)<=256u)?p0[r]+bb[r]:-1000.f; }
  __builtin_amdgcn_sched_barrier(0);
  #pragma unroll
  for(int r=0;r<16;++r){ const int rel=rel0+32+(r&3)+8*(r>>2); bb[r]=tab[min(max(rel+128,0),256)]; }
  __builtin_amdgcn_sched_barrier(0);
  #pragma unroll
  for(int r=0;r<16;++r){ const int rel=rel0+32+(r&3)+8*(r>>2); p1[r]=((unsigned)(rel+128)<=256u)?p1[r]+bb[r]:-1000.f; }
}
constexpr int NSLOT=3, SLOTB=8192;
constexpr int LDS_K=0, LDS_V=NSLOT*SLOTB, LDS_WS=2*NSLOT*SLOTB, LDS_OST=LDS_WS+NW*64*4, LDS_BYTES=LDS_OST+NW*4096;
constexpr float C2=0.125f*1.4426950408889634f;
__device__ __forceinline__ void glds16(const void*gsrc,unsigned lds_dst){unsigned keep;
  asm volatile("s_mov_b32 %0, m0\n\ts_mov_b32 m0, %2\n\ts_nop 0\n\tglobal_load_lds_dwordx4 %1, off\n\ts_mov_b32 m0, %0":"=&s"(keep):"v"(gsrc),"s"(lds_dst):"memory");}
__device__ __forceinline__ float max3f(float a,float b,float c){float r;asm("v_max3_f32 %0, %1, %2, %3":"=v"(r):"v"(a),"v"(b),"v"(c));return r;}
__device__ __forceinline__ float max2f(float a,float b){float r;asm("v_max_f32_e32 %0, %1, %2":"=v"(r):"v"(a),"v"(b));return r;}
__device__ __forceinline__ float fadd_s(float a,float b){float r;asm("v_add_f32_e32 %0, %1, %2":"=v"(r):"v"(a),"v"(b));return r;}
__device__ __forceinline__ float fsub_s(float a,float b){float r;asm("v_sub_f32_e32 %0, %1, %2":"=v"(r):"v"(a),"v"(b));return r;}
typedef float f32x2_t __attribute__((ext_vector_type(2))); typedef __bf16 bf16x2_t __attribute__((ext_vector_type(2)));
__device__ __forceinline__ unsigned cvtpk_s(float lo,float hi){f32x2_t v={lo,hi};bf16x2_t b=__builtin_convertvector(v,bf16x2_t);return __builtin_bit_cast(unsigned,b);}
#define WAIT_BAR(N) asm volatile("s_waitcnt vmcnt(" #N ") lgkmcnt(0)\n\ts_barrier":::"memory")

__device__ __forceinline__ void qkt(f32x16&p0,f32x16&p1,const char*Kslot,const bf16x8*qr,const f32x16&negm,int r32,int hi){
  const char*kb=Kslot+hi*1024+r32*16;
  #pragma unroll
  for(int d0=0;d0<4;++d0){
    const bf16x8 b0=*reinterpret_cast<const bf16x8*>(kb+d0*2048);
    const bf16x8 b1=*reinterpret_cast<const bf16x8*>(kb+d0*2048+512);
    if(d0==0){p0=__builtin_amdgcn_mfma_f32_32x32x16_bf16(b0,qr[0],negm,0,0,0);p1=__builtin_amdgcn_mfma_f32_32x32x16_bf16(b1,qr[0],negm,0,0,0);}
    else{p0=__builtin_amdgcn_mfma_f32_32x32x16_bf16(b0,qr[d0],p0,0,0,0);p1=__builtin_amdgcn_mfma_f32_32x32x16_bf16(b1,qr[d0],p1,0,0,0);}}
}
typedef __attribute__((address_space(3))) const char* lds_cptr;
typedef short v4i16_t __attribute__((ext_vector_type(4)));
__device__ __forceinline__ void kload8(bf16x8*kf,lds_cptr kp){
  kf[0]=*(const __attribute__((address_space(3))) bf16x8*)(kp);      kf[1]=*(const __attribute__((address_space(3))) bf16x8*)(kp+512);
  kf[2]=*(const __attribute__((address_space(3))) bf16x8*)(kp+2048); kf[3]=*(const __attribute__((address_space(3))) bf16x8*)(kp+2560);
  kf[4]=*(const __attribute__((address_space(3))) bf16x8*)(kp+4096); kf[5]=*(const __attribute__((address_space(3))) bf16x8*)(kp+4608);
  kf[6]=*(const __attribute__((address_space(3))) bf16x8*)(kp+6144); kf[7]=*(const __attribute__((address_space(3))) bf16x8*)(kp+6656);
}
__device__ __forceinline__ void kload2(bf16x8*kf,lds_cptr kp,int j){ kf[2*j]=*(const __attribute__((address_space(3))) bf16x8*)(kp+j*2048); kf[2*j+1]=*(const __attribute__((address_space(3))) bf16x8*)(kp+j*2048+512); }
__device__ __forceinline__ s16x4 vtr(lds_cptr p){ return __builtin_bit_cast(s16x4,__builtin_amdgcn_ds_read_tr16_b64_v4i16((__attribute__((address_space(3))) v4i16_t*)p)); }
__device__ __forceinline__ float rowmax(const f32x16&p0,const f32x16&p1){
  float a=max3f(p0[0],p0[1],p1[0]),b=max3f(p0[2],p0[3],p1[1]);a=max3f(a,p1[2],p1[3]);
  #pragma unroll
  for(int r=4;r<16;r+=4){a=max3f(a,p0[r],p0[r+1]);b=max3f(b,p0[r+2],p0[r+3]);a=max3f(a,p1[r],p1[r+1]);b=max3f(b,p1[r+2],p1[r+3]);}
  const float m=max2f(a,b);
  auto rr=__builtin_amdgcn_permlane32_swap(__float_as_uint(m),__float_as_uint(m),false,false);
  return max2f(__uint_as_float(rr[0]),__uint_as_float(rr[1]));
}
__device__ __forceinline__ void pv(f32x16*o,int vb,bf16x8 pa0,bf16x8 pa1,bf16x8 pa2,bf16x8 pa3){
  #pragma unroll
  for(int d0=0;d0<2;++d0){s16x4 lo[4],hi[4];
    #pragma unroll
    for(int ks=0;ks<4;++ks){
      asm volatile("ds_read_b64_tr_b16 %0,%1 offset:%c2":"=&v"(lo[ks]):"v"(vb),"i"(d0*4096+ks*1024):"memory");
      asm volatile("ds_read_b64_tr_b16 %0,%1 offset:%c2":"=&v"(hi[ks]):"v"(vb),"i"(d0*4096+ks*1024+512):"memory");}
    asm volatile("s_waitcnt lgkmcnt(0)":::"memory");SBAR();
    #define PK(k) (bf16x8){lo[k][0],lo[k][1],lo[k][2],lo[k][3],hi[k][0],hi[k][1],hi[k][2],hi[k][3]}
    o[d0]=__builtin_amdgcn_mfma_f32_32x32x16_bf16(pa0,PK(0),o[d0],0,0,0);
    o[d0]=__builtin_amdgcn_mfma_f32_32x32x16_bf16(pa1,PK(1),o[d0],0,0,0);
    o[d0]=__builtin_amdgcn_mfma_f32_32x32x16_bf16(pa2,PK(2),o[d0],0,0,0);
    o[d0]=__builtin_amdgcn_mfma_f32_32x32x16_bf16(pa3,PK(3),o[d0],0,0,0);
    #undef PK
  }
}

#ifndef ATTN_STORE16
#define ATTN_STORE16(p,v) (*(u32x4*)(p)=(v))
#endif
template<int THRL,int MODE> __device__ __forceinline__ void attn_unit(long rowbase,int q0,int kt0,int NT,const bf16*Q,const bf16*__restrict__ K,const bf16*__restrict__ V,bf16*O,char*shm,lds_fptr btab,float sinkl2,const int tid_in){
  int tid=tid_in; asm volatile("":"+v"(tid)); const int lane=tid&63,r32=lane&31,hi=lane>>5; const int wid=__builtin_amdgcn_readfirstlane(tid>>6);
    const bf16*Qw=Q+(rowbase+q0+wid*QBLK)*DM;
  const bf16*Kh=K+(rowbase+kt0)*DM,*Vh=V+(rowbase+kt0)*DM;
  const unsigned lds0=(unsigned)(uintptr_t)shm;
  float*wsf=(float*)(shm+LDS_WS)+wid*64;
  const bf16*ksrc=Kh+(long)lane*DM+wid*8;
  const bf16*vsrc=Vh+(long)(16*(wid&3)+(lane>>2))*DM+(wid>>2)*32+(lane&3)*8;
  const unsigned kdst=lds0+LDS_K+wid*1024, vdst=lds0+LDS_V+wid*1024;
  #define DMA_K(t,slot) glds16(ksrc+(long)(t)*KVBLK*DM,(unsigned)__builtin_amdgcn_readfirstlane(kdst+(slot)))
  #define DMA_V(t,slot) glds16(vsrc+(long)(t)*KVBLK*DM,(unsigned)__builtin_amdgcn_readfirstlane(vdst+(slot)))
  const int vb0=(int)(lds0+LDS_V)+((lane>>4)&1)*32+(lane&3)*8+(4*hi+((lane&15)>>2))*64;
  const char*Kbase=shm+LDS_K; bf16x8 kf[8];
  const lds_cptr shm3=(lds_cptr)shm; const lds_cptr kp0=shm3+LDS_K+hi*1024+r32*16; const lds_cptr vp0=shm3+LDS_V+((lane>>4)&1)*32+(lane&3)*8+(4*hi+((lane&15)>>2))*64;
  DMA_K(0,0);DMA_V(0,0);DMA_K(1,SLOTB);
  bf16x8 qr[4];
  #pragma unroll
  for(int d0=0;d0<4;++d0)qr[d0]=*reinterpret_cast<const bf16x8*>(&Qw[(long)r32*DM+d0*16+hi*8]);
  float mhat=0.f,l_reg=0.f;f32x16 o[2];o[0]=f32x16{};o[1]=f32x16{};f32x16 negm=f32x16{};asm volatile("":"+v"(negm));
  const int qrel=wid*QBLK+r32;
  #define CMASK(P0,P1,t) do{ if(MODE==1) bmask(P0,P1,kt0+64*(t)+4*hi-(q0+qrel),btab); }while(0)
  bool resc=false;
  #define START(P0,P1) do{ const float rm=rowmax(P0,P1); resc=false; \
    { const float dl=rm; mhat=fadd_s(mhat,dl); \
      _Pragma("unroll") for(int r=0;r<16;++r){P0[r]=fsub_s(P0[r],dl);P1[r]=fsub_s(P1[r],dl);} \
      _Pragma("unroll") for(int r=0;r<16;++r)negm[r]=-mhat; asm volatile("":"+v"(negm)); } \
    _Pragma("unroll") for(int r=0;r<16;++r)P0[r]=__builtin_amdgcn_exp2f(P0[r]); }while(0)
  #define RESC() do{ if(resc){ asm volatile("s_waitcnt lgkmcnt(0)":::"memory"); \
      _Pragma("unroll") for(int d_=0;d_<2;++d_) _Pragma("unroll") for(int r=0;r<16;++r)o[d_][r]*=wsf[crow(r,hi)]; } }while(0)
  f32x16 pA0,pA1,pB0,pB1;
  int sl_prev=0,sl_cur=0,sl_next=SLOTB;
  #define ROT() do{sl_prev=sl_cur;sl_cur=sl_next;sl_next=(sl_next==(NSLOT-1)*SLOTB)?0:sl_next+SLOTB;}while(0)
  DMA_K(2,2*SLOTB);
  WAIT_BAR(3);
  qkt(pA0,pA1,Kbase,qr,negm,r32,hi);asm volatile("s_nop 15\n\ts_nop 7":"+v"(pA0),"+v"(pA1));CMASK(pA0,pA1,0);
  START(pA0,pA1);
  _Pragma("unroll") for(int r=0;r<16;++r)pA1[r]=__builtin_amdgcn_exp2f(pA1[r]);
  WAIT_BAR(0);
  DMA_K(3,0);DMA_V(1,SLOTB);
  ROT();
  kload8(kf,kp0+sl_cur);
  WAIT_BAR(2);
  s16x4 vlo[8],vhi[8]; u32x4 pw0,pw1,pw2,pw3;
  #define PKW(P,B) cvtpk_s(P[B],P[B+1])
  #define PAF(k) __builtin_bit_cast(bf16x8,pw##k)
  #define VFR(i) (bf16x8){vlo[i][0],vlo[i][1],vlo[i][2],vlo[i][3],vhi[i][0],vhi[i][1],vhi[i][2],vhi[i][3]}
  #define PIN(x) asm volatile("":"+v"(x))
  #define MX3(a,b,c) __builtin_fmaxf(__builtin_fmaxf((a),(b)),(c))
  #define GAPA(MF,A0,A1,A2,A3,W0,W1,PW) do{ MF; sacc+=A0; sacc+=A1; sacc+=A2; sacc+=A3; PIN(sacc); W0; W1; PIN(PW); SBAR(); }while(0)
  #define EX(v) __builtin_amdgcn_exp2f(v)
  #define GAPB(MF,X,B) do{ MF; X[B]=EX(X[B]); X[B+1]=EX(X[B+1]); X[B+2]=EX(X[B+2]); X[B+3]=EX(X[B+3]); PIN(X); SBAR(); }while(0)
  #define VRD(i) do{ vlo[i]=vtr(vp_+(((i)>>2)*4096+((i)&3)*1024)); vhi[i]=vtr(vp_+(((i)>>2)*4096+((i)&3)*1024+512)); }while(0)
  #define KRD(G,j) do{ if(G){ kload2(kf,kp0+sl_next,j); SBAR(); } }while(0)
  #define STEP(C0,C1,P0,P1,t,GK,GV,GL) do{ SBAR(); \
    const lds_cptr vp_=vp0+sl_prev; \
    VRD(0); SBAR(); float sacc=(P0[0]+P0[1]); \
    GAPA(C0=__builtin_amdgcn_mfma_f32_32x32x16_bf16(kf[0],qr[0],negm,0,0,0), P0[2],P0[3],P0[4],P0[5],     pw0[0]=PKW(P0,0), pw0[1]=PKW(P0,2), pw0); \
    VRD(4); SBAR(); GAPA(C1=__builtin_amdgcn_mfma_f32_32x32x16_bf16(kf[1],qr[0],negm,0,0,0), P0[6],P0[7],P0[8],P0[9],     pw0[2]=PKW(P0,4), pw0[3]=PKW(P0,6), pw0); \
    VRD(1); SBAR(); GAPA(C0=__builtin_amdgcn_mfma_f32_32x32x16_bf16(kf[2],qr[1],C0,0,0,0),   P0[10],P0[11],P0[12],P0[13], pw1[0]=PKW(P0,8), pw1[1]=PKW(P0,10), pw1); \
    VRD(5); SBAR(); GAPA(C1=__builtin_amdgcn_mfma_f32_32x32x16_bf16(kf[3],qr[1],C1,0,0,0),   P0[14],P0[15],P1[0],P1[1],   pw1[2]=PKW(P0,12),pw1[3]=PKW(P0,14), pw1); \
    VRD(2); SBAR(); GAPA(C0=__builtin_amdgcn_mfma_f32_32x32x16_bf16(kf[4],qr[2],C0,0,0,0),   P1[2],P1[3],P1[4],P1[5],     pw2[0]=PKW(P1,0), pw2[1]=PKW(P1,2), pw2); \
    VRD(6); SBAR(); GAPA(C1=__builtin_amdgcn_mfma_f32_32x32x16_bf16(kf[5],qr[2],C1,0,0,0),   P1[6],P1[7],P1[8],P1[9],     pw2[2]=PKW(P1,4), pw2[3]=PKW(P1,6), pw2); \
    VRD(3); SBAR(); GAPA(C0=__builtin_amdgcn_mfma_f32_32x32x16_bf16(kf[6],qr[3],C0,0,0,0),   P1[10],P1[11],P1[12],P1[13], pw3[0]=PKW(P1,8), pw3[1]=PKW(P1,10), pw3); \
    VRD(7); SBAR(); GAPA(C1=__builtin_amdgcn_mfma_f32_32x32x16_bf16(kf[7],qr[3],C1,0,0,0),   P1[14],P1[15],0.f,0.f,       pw3[2]=PKW(P1,12),pw3[3]=PKW(P1,14), pw3); \
    l_reg+=sacc; \
    if(GK){DMA_K((t)+3,sl_cur);} if(GV){DMA_V((t)+1,sl_next);} \
    CMASK(C0,C1,t); \
    { float a=MX3(C0[0],C0[1],C1[0]),b=MX3(C0[2],C0[3],C1[1]); a=MX3(a,C1[2],C1[3]); \
      _Pragma("unroll") for(int r=4;r<16;r+=4){a=MX3(a,C0[r],C0[r+1]);b=MX3(b,C0[r+2],C0[r+3]);a=MX3(a,C1[r],C1[r+1]);b=MX3(b,C1[r+2],C1[r+3]);} \
      float rm=__builtin_fmaxf(a,b); { auto rr=__builtin_amdgcn_permlane32_swap(__float_as_uint(rm),__float_as_uint(rm),false,false); rm=__builtin_fmaxf(__uint_as_float(rr[0]),__uint_as_float(rr[1])); } \
      resc=false; \
      if(__builtin_expect(__any(rm>(float)THRL),0)){ const float dl=__builtin_fmaxf(rm,0.f); mhat+=dl; \
        _Pragma("unroll") for(int r=0;r<16;++r){C0[r]-=dl;C1[r]-=dl;} \
        _Pragma("unroll") for(int r=0;r<16;++r)negm[r]=-mhat; asm volatile("":"+v"(negm)); \
        const float f=__builtin_amdgcn_exp2f(-dl); l_reg*=f; if(hi==0)wsf[r32]=f; resc=true; } } \
    SBAR(); \
    GAPB(o[0]=__builtin_amdgcn_mfma_f32_32x32x16_bf16(PAF(0),VFR(0),o[0],0,0,0), C0,0); \
    GAPB(o[1]=__builtin_amdgcn_mfma_f32_32x32x16_bf16(PAF(0),VFR(4),o[1],0,0,0), C0,4); \
    KRD(GL,0); GAPB(o[0]=__builtin_amdgcn_mfma_f32_32x32x16_bf16(PAF(1),VFR(1),o[0],0,0,0), C0,8); \
    KRD(GL,1); GAPB(o[1]=__builtin_amdgcn_mfma_f32_32x32x16_bf16(PAF(1),VFR(5),o[1],0,0,0), C0,12); \
    KRD(GL,2); GAPB(o[0]=__builtin_amdgcn_mfma_f32_32x32x16_bf16(PAF(2),VFR(2),o[0],0,0,0), C1,0); \
    KRD(GL,3); GAPB(o[1]=__builtin_amdgcn_mfma_f32_32x32x16_bf16(PAF(2),VFR(6),o[1],0,0,0), C1,4); \
    GAPB(o[0]=__builtin_amdgcn_mfma_f32_32x32x16_bf16(PAF(3),VFR(3),o[0],0,0,0), C1,8); \
    GAPB(o[1]=__builtin_amdgcn_mfma_f32_32x32x16_bf16(PAF(3),VFR(7),o[1],0,0,0), C1,12); \
    }while(0)
  int t=1;
  for(;t+5<NT;t+=2){
    STEP(pB0,pB1,pA0,pA1,t,true,true,true);     WAIT_BAR(2); RESC(); ROT();
    STEP(pA0,pA1,pB0,pB1,t+1,true,true,true);   WAIT_BAR(2); RESC(); ROT();
  }
  #define ENDW(tt) do{ if((tt)+3<NT){WAIT_BAR(2);} else if((tt)+2<NT){WAIT_BAR(1);} else {WAIT_BAR(0);} }while(0)
  for(;t+1<NT;t+=2){
    STEP(pB0,pB1,pA0,pA1,t,(t+3<NT),(t+1<NT),(t+1<NT));       ENDW(t);   RESC(); ROT();
    STEP(pA0,pA1,pB0,pB1,t+1,(t+4<NT),(t+2<NT),(t+2<NT));     ENDW(t+1); RESC(); ROT();
  }
  STEP(pB0,pB1,pA0,pA1,NT-1,false,false,false); RESC();
  { float sacc=pB0[0]+pB0[1]; _Pragma("unroll") for(int r=2;r<16;++r)sacc+=pB0[r]; _Pragma("unroll") for(int r=0;r<16;++r)sacc+=pB1[r]; l_reg+=sacc;
    pw0=(u32x4){PKW(pB0,0),PKW(pB0,2),PKW(pB0,4),PKW(pB0,6)};pw1=(u32x4){PKW(pB0,8),PKW(pB0,10),PKW(pB0,12),PKW(pB0,14)};pw2=(u32x4){PKW(pB1,0),PKW(pB1,2),PKW(pB1,4),PKW(pB1,6)};pw3=(u32x4){PKW(pB1,8),PKW(pB1,10),PKW(pB1,12),PKW(pB1,14)};
    SBAR(); pv(o,vb0+sl_cur,PAF(0),PAF(1),PAF(2),PAF(3)); }
  #undef PKW
  #undef PAF
  #undef VFR
  #undef PIN
  #undef MX3
  #undef GAPA
  #undef GAPB
  #undef EX
  #undef VRD
  #undef KRD
  #undef STEP
  #undef ENDW
  {auto rr=__builtin_amdgcn_permlane32_swap(__float_as_uint(l_reg),__float_as_uint(l_reg),false,false);l_reg=__uint_as_float(rr[0])+__uint_as_float(rr[1]);}
  if(MODE==1) l_reg+=__builtin_amdgcn_exp2f(sinkl2-mhat);
  if(hi==0)wsf[32+r32]=l_reg;asm volatile("s_waitcnt lgkmcnt(0)":::"memory");
  float rli[16];
  #pragma unroll
  for(int r=0;r<16;++r)rli[r]=__builtin_amdgcn_rcpf(wsf[32+crow(r,hi)]);
  bf16*Ow=O+(rowbase+q0+wid*QBLK)*DM;
  { bf16*stg=(bf16*)(shm+LDS_OST)+wid*2048;
    #pragma unroll
    for(int r=0;r<16;++r){const int orow=crow(r,hi);
      #pragma unroll
      for(int d0=0;d0<2;++d0)stg[orow*64+d0*32+r32]=__float2bfloat16(o[d0][r]*rli[r]);}
    asm volatile("s_waitcnt lgkmcnt(0)":::"memory");
    #pragma unroll
    for(int i=0;i<4;++i){const int row=i*8+(lane>>3),ch=lane&7; const u32x4 v=*(const u32x4*)(stg+row*64+ch*8); ATTN_STORE16(Ow+(long)row*DM+ch*8,v);} }
  asm volatile("s_waitcnt lgkmcnt(0)\n\ts_barrier":::"memory");
  #undef DMA_K
  #undef DMA_V
  #undef CMASK
  #undef START
  #undef RESC
  #undef ROT
}
constexpr int ATTN_LDS_BYTES=LDS_BYTES;
#undef SBAR
#undef WAIT_BAR
}
#define LAS __attribute__((address_space(3)))
typedef unsigned short bf16_t;
typedef unsigned u32x4 __attribute__((ext_vector_type(4)));
typedef unsigned u32x2 __attribute__((ext_vector_type(2)));
typedef float f32x4 __attribute__((ext_vector_type(4)));
typedef short bf16x8 __attribute__((ext_vector_type(8)));

#ifndef MK_MULTI
#define MK_MULTI 0
#endif
#ifndef PROBE
#define PROBE 0
#endif
#ifndef PH_MASK
#define PH_MASK 0xFFFF
#endif
#define PHON(k) ((MASK >> (k)) & 1)
constexpr int NWAVES = 8, NTHR = 512, LDS_BYTES = 155648;
constexpr int NPH = 2 * 16 + 1;
constexpr size_t WS_HB = 0;
constexpr size_t WS_XB = WS_HB + (size_t)GT * PITCH * 2;
constexpr size_t WS_W1 = WS_XB + (size_t)GT * DMODEL * 2;
constexpr size_t WS_WB = WS_W1 + (size_t)5632 * 1024 * 2;
constexpr size_t WS_WO = WS_WB + (size_t)1024 * 1536 * 2;
constexpr size_t WS_WU = WS_WO + (size_t)1024 * 1024 * 2;
constexpr size_t WS_WD = WS_WU + (size_t)5632 * 1024 * 2;
constexpr size_t WS_HALO = WS_WD + (size_t)1024 * 2816 * 2;
constexpr size_t WS_SSQ1 = WS_HALO + (size_t)512 * PITCH * 2;
constexpr size_t WS_SSQ2 = WS_SSQ1 + (size_t)GT * 4;
constexpr size_t WS_BAR = WS_SSQ2 + (size_t)GT * 4;
constexpr size_t WS_END = WS_BAR + 16384;
static_assert(WS_END <= 268435456, "workspace map exceeds 256 MiB");

struct Params { const float* in[22]; float* out; unsigned char* ws; int lo, hi; };
enum { I_XP = 0, I_XS, I_RELB, I_N1G, I_WIN, I_LNG, I_LNB, I_WSP, I_BSP, I_SINK, I_QNG, I_KNG, I_WGATE, I_BGATE, I_WBR, I_WOUT, I_N2G, I_WUP, I_CW, I_CB, I_WDN, I_FING };

__device__ __forceinline__ const float* inp(const Params& P, int i) { asm volatile("" : "+s"(i)); return P.in[i]; }
__device__ __forceinline__ float wave_sum(float v) {
#pragma unroll
    for (int o = 1; o < 64; o <<= 1) v += __shfl_xor(v, o);
    return v;
}
__device__ __forceinline__ float bflo(unsigned w) { return __uint_as_float(w << 16); }
__device__ __forceinline__ float bfhi(unsigned w) { return __uint_as_float(w & 0xffff0000u); }
__device__ __forceinline__ unsigned short f2bf1(float f) { return (unsigned short)(pg8::cvt_pk_bf16(f, 0.f) & 0xffffu); }

struct WTile { const float* W; const float* gk; bf16_t* WT; int K, N, k0, n0, drow0; };
__device__ __forceinline__ WTile wprep_desc(const Params& P, unsigned char* ws, int l, int it) {
    WTile d; int r = it;
    const float* g1 = inp(P, I_N1G) + l * 1024; const float* g2 = inp(P, I_N2G) + l * 1024;
    if (r < 640) { const int kb = r / 40, nb = r % 40, sb = nb >> 1; const int db = sb < 4 ? sb : sb < 8 ? sb + 8 : sb < 12 ? sb - 4 : sb < 14 ? sb + 4 : sb < 18 ? sb - 6 : sb;
        d.W = inp(P, I_WIN) + (size_t)l * 1024 * 2560; d.K = 1024; d.N = 2560; d.k0 = kb * 64; d.n0 = nb * 64; d.gk = g1; d.WT = (bf16_t*)(ws + WS_W1); d.drow0 = db * 128 + (nb & 1) * 64; return d; } r -= 640;
    if (r < 768) { const int kb = r / 48, nb = r % 48; d.W = inp(P, I_WGATE) + (size_t)l * 1024 * 3072; d.K = 1024; d.N = 3072; d.k0 = kb * 64; d.n0 = nb * 64; d.gk = g1; d.WT = (bf16_t*)(ws + WS_W1); d.drow0 = 2560 + nb * 64; return d; } r -= 768;
    if (r < 384) { const int kb = r / 16, nb = r % 16; d.W = inp(P, I_WBR) + (size_t)l * 1536 * 1024; d.K = 1536; d.N = 1024; d.k0 = kb * 64; d.n0 = nb * 64; d.gk = nullptr; d.WT = (bf16_t*)(ws + WS_WB); d.drow0 = nb * 64; return d; } r -= 384;
    if (r < 256) { const int kb = r / 16, nb = r % 16; d.W = inp(P, I_WOUT) + (size_t)l * 1024 * 1024; d.K = 1024; d.N = 1024; d.k0 = kb * 64; d.n0 = nb * 64; d.gk = nullptr; d.WT = (bf16_t*)(ws + WS_WO); d.drow0 = nb * 64; return d; } r -= 256;
    if (r < 1408) { const int kb = r / 88, nb = r % 88; const int nv = nb >= 44 ? nb - 44 : nb;
        d.W = inp(P, I_WUP) + (size_t)l * 1024 * 5632; d.K = 1024; d.N = 5632; d.k0 = kb * 64; d.n0 = nb * 64; d.gk = g2; d.WT = (bf16_t*)(ws + WS_WU); d.drow0 = 256 * (nv >> 1) + (nb >= 44 ? 128 : 0) + 64 * (nv & 1); return d; } r -= 1408;
    { const int kb = r / 16, nb = r % 16; d.W = inp(P, I_WDN) + (size_t)l * 2816 * 1024; d.K = 2816; d.N = 1024; d.k0 = kb * 64; d.n0 = nb * 64; d.gk = nullptr; d.WT = (bf16_t*)(ws + WS_WD); d.drow0 = nb * 64; return d; }
}
__device__ __forceinline__ void wprep_load(const WTile& d, float (&v)[8], int tid) {
#pragma unroll
    for (int i = 0; i < 8; ++i) { const int kk = i * 8 + (tid >> 6), nn = tid & 63; float x = d.W[(size_t)(d.k0 + kk) * d.N + d.n0 + nn]; if (d.gk) x *= d.gk[d.k0 + kk]; v[i] = x; }
}
__device__ __forceinline__ void ph_wprep(const Params& P, int bid, int G, unsigned char* ws, int l, LAS unsigned char* lds, int tid) {
    asm volatile("" : "+v"(tid)); asm volatile("" : "+s"(bid)); asm volatile("" : "+s"(G));
    LAS float* scr = (LAS float*)lds;
    int it = bid; if (it >= 4160) return;
    WTile d = wprep_desc(P, ws, l, it); float v[8]; wprep_load(d, v, tid);
#pragma unroll 1
    for (;;) {
#pragma unroll
        for (int i = 0; i < 8; ++i) { const int kk = i * 8 + (tid >> 6), nn = tid & 63; scr[kk * 65 + nn] = v[i]; }
        __syncthreads();
        const WTile cur = d; const int nit = it + G; const bool more = nit < 4160;
        if (more) { d = wprep_desc(P, ws, l, nit); wprep_load(d, v, tid); }
        { const int n = tid >> 3, c = tid & 7; const LAS float* s = scr + (8 * c) * 65 + n;
          u32x4 o; o.x = pg8::cvt_pk_bf16(s[0], s[65]); o.y = pg8::cvt_pk_bf16(s[130], s[195]); o.z = pg8::cvt_pk_bf16(s[260], s[325]); o.w = pg8::cvt_pk_bf16(s[390], s[455]);
          *(u32x4*)(cur.WT + (size_t)(cur.drow0 + n) * cur.K + cur.k0 + 8 * c) = o; }
        __syncthreads();
        if (!more) break;
        it = nit;
    }
}

__device__ __forceinline__ void ph_p1(int bid, int G, unsigned char* ws, const float* xsrc, int tid) {
    asm volatile("" : "+v"(tid)); asm volatile("" : "+s"(bid)); asm volatile("" : "+s"(G));
    const int lane = tid & 63, wave = tid >> 6; bf16_t* XB = (bf16_t*)(ws + WS_XB); float* ssq1 = (float*)(ws + WS_SSQ1); float* ssq2 = (float*)(ws + WS_SSQ2);
    const int NGW = G * NWAVES;
    for (int row = bid * NWAVES + wave; row < GT; row += 2 * NGW) {
        const int row2 = row + NGW; const bool has2 = row2 < GT;
        const f32x4* xr = (const f32x4*)(xsrc + (size_t)row * DMODEL) + lane; const f32x4* xr2 = (const f32x4*)(xsrc + (size_t)(has2 ? row2 : row) * DMODEL) + lane;
        f32x4 v[4], v2[4]; float s = 0.f, s2 = 0.f;
#pragma unroll
        for (int j = 0; j < 4; ++j) { v[j] = xr[64 * j]; v2[j] = xr2[64 * j]; }
#pragma unroll
        for (int j = 0; j < 4; ++j) { s += (v[j].x * v[j].x + v[j].y * v[j].y) + (v[j].z * v[j].z + v[j].w * v[j].w); s2 += (v2[j].x * v2[j].x + v2[j].y * v2[j].y) + (v2[j].z * v2[j].z + v2[j].w * v2[j].w); }
        s = wave_sum(s); s2 = wave_sum(s2);
        u32x2* o = (u32x2*)(XB + (size_t)row * DMODEL) + lane;
#pragma unroll
        for (int j = 0; j < 4; ++j) { u32x2 w; w.x = pg8::cvt_pk_bf16(v[j].x, v[j].y); w.y = pg8::cvt_pk_bf16(v[j].z, v[j].w); o[64 * j] = w; }
        if (lane == 0) { ssq1[row] = s; ssq2[row] = 0.f; }
        if (has2) {
            u32x2* o2 = (u32x2*)(XB + (size_t)row2 * DMODEL) + lane;
#pragma unroll
            for (int j = 0; j < 4; ++j) { u32x2 w; w.x = pg8::cvt_pk_bf16(v2[j].x, v2[j].y); w.y = pg8::cvt_pk_bf16(v2[j].z, v2[j].w); o2[64 * j] = w; }
            if (lane == 0) { ssq1[row2] = s2; ssq2[row2] = 0.f; }
        }
    }
}

__device__ __forceinline__ void mixer_a_item(const Params& P, int l, int it, int par, bf16_t* HB, LAS unsigned char* lds, int tid) {
    const int ch = it >> 3, g8 = it & 7, r0 = ch * 128, lane = tid & 63, w = tid >> 6;
    LAS bf16_t* vT = (LAS bf16_t*)(lds + 16384 + par * 17408);
    const float* wsp = inp(P, I_WSP) + (((size_t)l * 8 + g8) * 128 + 16 * w + (lane & 15)) * 128 + 8 * (lane >> 4);
    f32x4 araw[8];
#pragma unroll
    for (int ks = 0; ks < 4; ++ks) { araw[2 * ks] = *(const f32x4*)(wsp + ks * 32); araw[2 * ks + 1] = *(const f32x4*)(wsp + ks * 32 + 4); }
    bf16_t* ub = HB + (size_t)(r0 + 16 * w + (lane & 15)) * PITCH + COL_U + g8 * 64 + 4 * (lane >> 4);
    u32x2 uraw[4];
#pragma unroll
    for (int nb = 0; nb < 4; ++nb) uraw[nb] = *(const u32x2*)(ub + 16 * nb);
    const float bs1 = inp(P, I_BSP)[((size_t)l * 8 + g8) * 128 + 16 * w + (lane & 15)];
    {
        const int q = tid >> 2, part = tid & 3;
        const bf16_t* vp = HB + (size_t)(r0 + q) * PITCH + COL_VA + part * 128;
        const int c0 = part * 16; const bf16_t* gp = HB + (size_t)(r0 + q) * PITCH + COL_VA + g8 * 64 + c0;
        const float* lg = inp(P, I_LNG) + l * 512 + g8 * 64 + c0; const float* lb = inp(P, I_LNB) + l * 512 + g8 * 64 + c0;
        u32x4 sv[16], gvw[2]; f32x4 lgv[4], lbv[4];
#pragma unroll
        for (int i = 0; i < 16; ++i) sv[i] = *(const u32x4*)(vp + 8 * i);
#pragma unroll
        for (int hh = 0; hh < 2; ++hh) gvw[hh] = *(const u32x4*)(gp + 8 * hh);
#pragma unroll
        for (int i = 0; i < 4; ++i) { lgv[i] = *(const f32x4*)(lg + 4 * i); lbv[i] = *(const f32x4*)(lb + 4 * i); }
        __builtin_amdgcn_sched_barrier(0);
        float s = 0.f, s2 = 0.f;
#pragma unroll
        for (int i = 0; i < 16; ++i) {
#pragma unroll
            for (int e = 0; e < 4; ++e) { const float a = bflo(sv[i][e]), b = bfhi(sv[i][e]); s += a + b; s2 += a * a + b * b; } }
        s += __shfl_xor(s, 1); s += __shfl_xor(s, 2); s2 += __shfl_xor(s2, 1); s2 += __shfl_xor(s2, 2);
        const float mean = s * (1.0f / 512.0f), var = fmaxf(s2 * (1.0f / 512.0f) - mean * mean, 0.f), rstd = rsqrtf(var + EPSN);
#pragma unroll
        for (int hh = 0; hh < 2; ++hh) { const u32x4 wv = gvw[hh];
#pragma unroll
            for (int e = 0; e < 4; ++e) { const int i = hh * 8 + e * 2;
                const float ga = lgv[i >> 2][i & 3], gb = lgv[(i + 1) >> 2][(i + 1) & 3], ba = lbv[i >> 2][i & 3], bb = lbv[(i + 1) >> 2][(i + 1) & 3];
                const float y0 = (bflo(wv[e]) - mean) * rstd * ga + ba, y1 = (bfhi(wv[e]) - mean) * rstd * gb + bb;
                vT[(c0 + i) * 136 + q] = f2bf1(y0); vT[(c0 + i + 1) * 136 + q] = f2bf1(y1); } }
    }
    __builtin_amdgcn_sched_barrier(0);
    bf16x8 afr[4];
#pragma unroll
    for (int ks = 0; ks < 4; ++ks) { const u32x4 aw = pg8::pack8(araw[2 * ks], araw[2 * ks + 1]); afr[ks] = __builtin_bit_cast(bf16x8, aw); }
    __syncthreads();
    f32x4 acc[4];
#pragma unroll
    for (int nb = 0; nb < 4; ++nb) acc[nb] = (f32x4){0.f, 0.f, 0.f, 0.f};
#pragma unroll
    for (int ks = 0; ks < 4; ++ks) {
#pragma unroll
        for (int nb = 0; nb < 4; ++nb) { const bf16x8 b = *(const LAS bf16x8*)(vT + (16 * nb + (lane & 15)) * 136 + ks * 32 + 8 * (lane >> 4));
            acc[nb] = __builtin_amdgcn_mfma_f32_16x16x32_bf16(b, afr[ks], acc[nb], 0, 0, 0); }
        __builtin_amdgcn_sched_barrier(0);
    }
#pragma unroll
    for (int nb = 0; nb < 4; ++nb) {
        u32x2 o; o.x = pg8::cvt_pk_bf16(bflo(uraw[nb].x) * (acc[nb][0] + bs1), bfhi(uraw[nb].x) * (acc[nb][1] + bs1)); o.y = pg8::cvt_pk_bf16(bflo(uraw[nb].y) * (acc[nb][2] + bs1), bfhi(uraw[nb].y) * (acc[nb][3] + bs1));
        *(u32x2*)(ub + 16 * nb) = o;
        __builtin_amdgcn_sched_barrier(0); }
}
__device__ __forceinline__ void ph_p3a(const Params& P, int bid, int G, unsigned char* ws, int l, int g, LAS unsigned char* lds, int tid, const int mode = 0) {
    asm volatile("" : "+v"(tid)); asm volatile("" : "+s"(bid)); asm volatile("" : "+s"(G));
    bf16_t* HB = (bf16_t*)(ws + WS_HB);
    LAS float* tab = (LAS float*)lds;
    for (int e = tid; e < 1024; e += NTHR) { const int pos = e >> 4, i = e & 15; const float inv = __builtin_amdgcn_exp2f(-(float)i * (13.287712379549449f / 16.0f)), rev = (float)pos * inv * 0.15915494309189535f; tab[2 * e] = __builtin_amdgcn_cosf(rev); tab[2 * e + 1] = __builtin_amdgcn_sinf(rev); }
    __syncthreads();
    if (mode != 2) { int par = 0;
#pragma unroll 1
      for (int i = 0, it0 = bid; it0 < 1024; ++i, it0 += G) {
          int it = it0; if (G == 256) { const int x = bid & 7, j = (bid >> 3) + 32 * i; it = ((x * 16 + (j >> 3)) << 3) + (j & 7); }
          mixer_a_item(P, l, it, par, HB, lds, tid); par ^= 1; } }
    __syncthreads();
    const int S = g == 0 ? 2048 : 4096;
    if (mode != 1)
    for (int idx = bid * NTHR + tid; idx < GT * 20; idx += G * NTHR) {
        const int half = idx & 1, th = idx >> 1, t = th / 10, hh = th - t * 10; const bool isq = hh < 8;
        bf16_t* p = HB + (size_t)t * PITCH + (isq ? COL_QC + hh * 64 : COL_KC + (hh - 8) * 64) + half * 32;
        const float* gain = (isq ? inp(P, I_QNG) : inp(P, I_KNG)) + l * 64 + half * 32; const float sc = isq ? QK_C2 : 1.0f;
        float x[32]; float ssq = 0.f;
        u32x4 xw[4]; f32x4 gvv[8];
#pragma unroll
        for (int i = 0; i < 4; ++i) xw[i] = *(const u32x4*)(p + 8 * i);
#pragma unroll
        for (int i = 0; i < 8; ++i) gvv[i] = *(const f32x4*)(gain + 4 * i);
        __builtin_amdgcn_sched_barrier(0);
#pragma unroll
        for (int i = 0; i < 4; ++i) {
#pragma unroll
            for (int e = 0; e < 4; ++e) { x[8 * i + 2 * e] = bflo(xw[i][e]); x[8 * i + 2 * e + 1] = bfhi(xw[i][e]); } }
#pragma unroll
        for (int i = 0; i < 32; ++i) ssq += x[i] * x[i];
        ssq += __shfl_xor(ssq, 1);
        const float rstd = rsqrtf(ssq * (1.0f / 64.0f) + EPSN);
#pragma unroll
        for (int i = 0; i < 8; ++i) {
#pragma unroll
            for (int e = 0; e < 4; ++e) x[4 * i + e] = x[4 * i + e] * rstd * gvv[i][e]; }
        const int ts = t & (S - 1), pos = half ? (ts & 63) : (ts >> 6);
#pragma unroll
        for (int i = 0; i < 16; ++i) { const float cs = tab[(pos * 16 + i) * 2], sn = tab[(pos * 16 + i) * 2 + 1]; const float x1 = x[i], x2 = x[16 + i];
            x[i] = (x1 * cs - x2 * sn) * sc; x[16 + i] = (x2 * cs + x1 * sn) * sc; }
#pragma unroll
        for (int i = 0; i < 4; ++i) { u32x4 wv;
#pragma unroll
            for (int e = 0; e < 4; ++e) wv[e] = pg8::cvt_pk_bf16(x[8 * i + 2 * e], x[8 * i + 2 * e + 1]);
            *(u32x4*)(p + 8 * i) = wv; }
    }
}

__device__ __forceinline__ int t5_bucket(int rel) {
    const int n = rel < 0 ? -rel : rel; int b;
    if (n < 8) b = n; else { b = 8 + (n >= 12) + (n >= 16) + (n >= 23) + (n >= 32) + (n >= 46) + (n >= 64) + (n >= 91); }
    return b + (rel > 0 ? 16 : 0);
}
constexpr int BT_OFF = 86016, BT_PITCH = 260;
__device__ __forceinline__ void ph_p3b(const Params& P, int bid, int G, unsigned char* ws, int l, int g, unsigned char* lds_gen, LAS unsigned char* lds, int tid, const int which = 0) {
    asm volatile("" : "+v"(tid)); asm volatile("" : "+s"(bid)); asm volatile("" : "+s"(G));
    using abf = attn_body::bf16;
    LAS float* bt = (LAS float*)(lds + BT_OFF);
    for (int e = tid; e < 8 * 257; e += NTHR) { const int h = e / 257, i = e - h * 257; bt[h * BT_PITCH + i] = inp(P, I_RELB)[t5_bucket(i - 128) * 8 + h] * 1.4426950408889634f; }
    __syncthreads();
    const abf* HB = (const abf*)(ws + WS_HB); abf* HBw = (abf*)(ws + WS_HB);
    const int S = g == 0 ? 2048 : 4096;
    if (which != 2)
    for (int u = bid; u < 512; u += G) {
        const int h = u & 7, r = (u >> 3) * 256, q0 = r & (S - 1); const long rowbase = r - q0;
        attn_body::attn_unit<8, 0>(rowbase, q0, 0, S / 64, HB + COL_QC + h * 64, HB + COL_KC + (h >> 2) * 64, HB + COL_VC + (h >> 2) * 64, HBw + COL_QC + h * 64, (char*)lds_gen, (attn_body::lds_fptr)bt, 0.f, tid);
    }
    if (which != 1)
    for (int u = bid; u < 512; u += G) {
        const int h = u & 7, r = (u >> 3) * 256, q0 = r & (S - 1); const long rowbase = r - q0;
        const int kt0 = q0 >= 128 ? q0 - 128 : 0, kend = (q0 + 384 <= S) ? q0 + 384 : S;
        attn_body::attn_unit<8, 1>(rowbase, q0, kt0, (kend - kt0) / 64, HB + COL_QB + h * 64, HB + COL_KB + (h >> 2) * 64, HB + COL_VB + (h >> 2) * 64, HBw + COL_QB + h * 64, (char*)lds_gen,
                                   (attn_body::lds_fptr)(bt + h * BT_PITCH), inp(P, I_SINK)[l * 8 + h] * 1.4426950408889634f, tid);
    }
}

__device__ __forceinline__ void unpack8(const u32x4 w, float (&o)[8]) {
#pragma unroll
    for (int e = 0; e < 4; ++e) { o[2 * e] = bflo(w[e]); o[2 * e + 1] = bfhi(w[e]); }
}
__device__ __forceinline__ void ph_conv(const Params& P, int bid, int G, unsigned char* ws, int l, int g, int tid) {
    asm volatile("" : "+v"(tid)); asm volatile("" : "+s"(bid)); asm volatile("" : "+s"(G));
    bf16_t* HB = (bf16_t*)(ws + WS_HB); const bf16_t* halo = (const bf16_t*)(ws + WS_HALO);
    const int S = g == 0 ? 2048 : 4096;
    const float* cw = inp(P, I_CW) + (size_t)l * 3 * 5632; const float* cb = inp(P, I_CB) + (size_t)l * 5632;
    for (int gt = bid * NTHR + tid; gt < 256 * 352; gt += G * NTHR) {
        const int rb = gt / 352, ci = gt - rb * 352, r0 = rb * 64, cg0 = ci * 8, cv0 = DFF + ci * 8;
        float wg[3][8], wv[3][8], bg[8], bv[8];
#pragma unroll
        for (int k = 0; k < 3; ++k)
#pragma unroll
            for (int e = 0; e < 8; ++e) { wg[k][e] = cw[k * 5632 + cg0 + e]; wv[k][e] = cw[k * 5632 + cv0 + e]; }
#pragma unroll
        for (int e = 0; e < 8; ++e) { bg[e] = cb[cg0 + e]; bv[e] = cb[cv0 + e]; }
        const bool topz = (r0 & (S - 1)) == 0, botz = ((r0 + 64) & (S - 1)) == 0;
        float pgt[8], pvl[8], cgt[8], cvl[8];
        if (topz) {
#pragma unroll
            for (int e = 0; e < 8; ++e) { pgt[e] = 0.f; pvl[e] = 0.f; }
        } else { const bf16_t* hp = halo + (size_t)((rb - 1) * 2 + 1) * PITCH; unpack8(*(const u32x4*)(hp + cg0), pgt); unpack8(*(const u32x4*)(hp + cv0), pvl); }
        { const bf16_t* rp = HB + (size_t)r0 * PITCH; unpack8(*(const u32x4*)(rp + cg0), cgt); unpack8(*(const u32x4*)(rp + cv0), cvl); }
#pragma unroll 1
        for (int rr = 0; rr < 64; rr += 8) {
            u32x4 ng[8], nv[8];
#pragma unroll
            for (int j = 0; j < 8; ++j) {
                if (rr + j + 1 < 64) { const bf16_t* rp = HB + (size_t)(r0 + rr + j + 1) * PITCH; ng[j] = *(const u32x4*)(rp + cg0); nv[j] = *(const u32x4*)(rp + cv0); }
                else if (botz) { ng[j] = (u32x4){0u, 0u, 0u, 0u}; nv[j] = (u32x4){0u, 0u, 0u, 0u}; }
                else { const bf16_t* hp = halo + (size_t)((rb + 1) * 2) * PITCH; ng[j] = *(const u32x4*)(hp + cg0); nv[j] = *(const u32x4*)(hp + cv0); }
            }
#pragma unroll
            for (int j = 0; j < 8; ++j) {
                float ngt[8], nvl[8]; unpack8(ng[j], ngt); unpack8(nv[j], nvl);
                float o[8];
#pragma unroll
                for (int e = 0; e < 8; ++e) { const float a = pgt[e] * wg[0][e] + cgt[e] * wg[1][e] + ngt[e] * wg[2][e] + bg[e]; const float b = pvl[e] * wv[0][e] + cvl[e] * wv[1][e] + nvl[e] * wv[2][e] + bv[e];
                    o[e] = pg8::silu_f(a) * b; pgt[e] = cgt[e]; pvl[e] = cvl[e]; cgt[e] = ngt[e]; cvl[e] = nvl[e]; }
                u32x4 w; w.x = pg8::cvt_pk_bf16(o[0], o[1]); w.y = pg8::cvt_pk_bf16(o[2], o[3]); w.z = pg8::cvt_pk_bf16(o[4], o[5]); w.w = pg8::cvt_pk_bf16(o[6], o[7]);
                *(u32x4*)(HB + (size_t)(r0 + rr + j) * PITCH + cg0) = w;
            }
        }
    }
}

__device__ __forceinline__ void ph_final(const Params& P, int bid, int G, int tid) {
    asm volatile("" : "+v"(tid)); asm volatile("" : "+s"(bid)); asm volatile("" : "+s"(G));
    const int lane = tid & 63, wave = tid >> 6; const f32x4* gp = (const f32x4*)inp(P, I_FING) + lane;
    const int NGW = G * NWAVES;
    f32x4 gv[4];
#pragma unroll
    for (int j = 0; j < 4; ++j) gv[j] = gp[64 * j];
    for (int row = bid * NWAVES + wave; row < 2 * GT; row += 2 * NGW) {
        const int row2 = row + NGW; const bool has2 = row2 < 2 * GT;
        f32x4* xr = (f32x4*)(P.out + (size_t)row * DMODEL) + lane; f32x4* xr2 = (f32x4*)(P.out + (size_t)(has2 ? row2 : row) * DMODEL) + lane;
        f32x4 v[4], v2[4]; float s = 0.f, s2 = 0.f;
#pragma unroll
        for (int j = 0; j < 4; ++j) { v[j] = xr[64 * j]; v2[j] = xr2[64 * j]; }
#pragma unroll
        for (int j = 0; j < 4; ++j) { s += (v[j].x * v[j].x + v[j].y * v[j].y) + (v[j].z * v[j].z + v[j].w * v[j].w); s2 += (v2[j].x * v2[j].x + v2[j].y * v2[j].y) + (v2[j].z * v2[j].z + v2[j].w * v2[j].w); }
        const float rs = rsqrtf(wave_sum(s) * (1.0f / 1024.0f) + EPSN), rs2 = rsqrtf(wave_sum(s2) * (1.0f / 1024.0f) + EPSN);
#pragma unroll
        for (int j = 0; j < 4; ++j) xr[64 * j] = v[j] * rs * gv[j];
        if (has2) {
#pragma unroll
            for (int j = 0; j < 4; ++j) xr2[64 * j] = v2[j] * rs2 * gv[j];
        }
    }
}

#define XB_TMO      128
#define XB_XCNT(j)  (256  + 64 * (j))
#define XB_XSUB(j)  (1280 + 64 * (j))
#define XB_XGEN(j)  (2304 + 64 * (j))
#define XB_TOP      3328
#define XB_TOPGEN   3392
#define XCD_BAR_WORDS 3456
#define XB_SPIN_CAP (1u << 22)
__device__ __forceinline__ unsigned xb_ld(unsigned* p)              { return __hip_atomic_load(p, __ATOMIC_RELAXED, __HIP_MEMORY_SCOPE_AGENT); }
__device__ __forceinline__ unsigned xb_add(unsigned* p, unsigned v) { return __hip_atomic_fetch_add(p, v, __ATOMIC_RELAXED, __HIP_MEMORY_SCOPE_AGENT); }
__device__ __forceinline__ unsigned xb_xcc_id() { return (unsigned)__builtin_amdgcn_s_getreg((3 << 11) | 20) & 0xFu; }
#define XB_SPIN(cond, bar) do { unsigned _sp = 0; while (cond) { __builtin_amdgcn_s_sleep(1); \
    if ((++_sp & 255u) == 0u) { if (xb_ld(&(bar)[XB_TMO])) break; if (_sp > XB_SPIN_CAP) { atomicAdd(&(bar)[XB_TMO], 1u); break; } } } } while (0)
__device__ __forceinline__ void xcd_barrier_complete(unsigned* bar, unsigned x, unsigned G, unsigned& nloc, unsigned& nx) {
    unsigned sum, cnt, mine, sp = 0u;
    for (;;) {
        sum = 0u; cnt = 0u; mine = 0u;
#pragma unroll
        for (unsigned j = 0; j < 16; ++j) { const unsigned c = xb_ld(&bar[XB_XCNT(j)]); sum += c; cnt += (c > 0u) ? 1u : 0u; mine = (j == x) ? c : mine; }
        if (sum == G) break;
        __builtin_amdgcn_s_sleep(1);
        if ((++sp & 255u) == 0u) { if (xb_ld(&bar[XB_TMO])) break; if (sp > XB_SPIN_CAP) { atomicAdd(&bar[XB_TMO], 1u); break; } }
    }
    nloc = mine > 0u ? mine : 1u; nx = cnt > 0u ? cnt : 1u;
}
__device__ __forceinline__ void grid_bar(unsigned* bar, volatile LAS unsigned* st, unsigned G, int tid) {
    asm volatile("s_waitcnt vmcnt(0) lgkmcnt(0)" ::: "memory");
    __syncthreads();
    if (tid == 0) {
        const unsigned x = xb_xcc_id();
        __builtin_amdgcn_s_waitcnt(0);
        unsigned nloc = st[0], nx = st[1];
        if (nloc == 0u) { xcd_barrier_complete(bar, x, G, nloc, nx); st[0] = nloc; st[1] = nx; }
        const unsigned old = xb_add(&bar[XB_XSUB(x)], 1u);
        const unsigned gen = old / nloc;
        if (old + 1u == (gen + 1u) * nloc) {
            __builtin_amdgcn_fence(__ATOMIC_RELEASE, "agent");
            asm volatile("s_waitcnt vmcnt(0)" ::: "memory");
            const unsigned og = xb_add(&bar[XB_TOP], 1u);
            const unsigned tg = og / nx;
            if (og + 1u == (tg + 1u) * nx) xb_add(&bar[XB_TOPGEN], 1u);
            else XB_SPIN(xb_ld(&bar[XB_TOPGEN]) == tg, bar);
            __builtin_amdgcn_fence(__ATOMIC_ACQUIRE, "agent");
            xb_add(&bar[XB_XGEN(x)], 1u);
            asm volatile("s_waitcnt vmcnt(0)" ::: "memory");
        } else {
            XB_SPIN(xb_ld(&bar[XB_XGEN(x)]) == gen, bar);
            __builtin_amdgcn_fence(__ATOMIC_ACQUIRE, "agent");
            asm volatile("s_waitcnt vmcnt(0)" ::: "memory");
        }
    }
    __syncthreads();
}
constexpr int BARST_OFF = LDS_BYTES - 64;
#define PH_BEGIN(I) { int lo = P.lo, hi = P.hi; asm volatile("" : "+v"(lo)); asm volatile("" : "+v"(hi));   if ((I) >= lo && (I) < hi) { \
        int tid = wave_s * 64 + (int)__builtin_amdgcn_mbcnt_hi(~0u, __builtin_amdgcn_mbcnt_lo(~0u, 0u)); asm volatile("" : "+v"(tid)); \
        unsigned char* ws = P.ws; asm volatile("" : "+s"(ws)); int G = gridDim.x; asm volatile("" : "+s"(G)); int bid = blockIdx.x; asm volatile("" : "+s"(bid)); \
        if ((I) > lo) grid_bar((unsigned*)(ws + WS_BAR), (volatile LAS unsigned*)(lds + BARST_OFF), (unsigned)G, tid); \
        bf16_t* HB = (bf16_t*)(ws + WS_HB); bf16_t* XB = (bf16_t*)(ws + WS_XB); float* ssq1 = (float*)(ws + WS_SSQ1); float* ssq2 = (float*)(ws + WS_SSQ2); (void)HB; (void)XB; (void)ssq1; (void)ssq2; (void)tid; (void)G; (void)bid;
#define PH_END } }
#define BAR2(k) grid_bar((unsigned*)(ws + WS_BAR), (volatile LAS unsigned*)(lds + BARST_OFF), (unsigned)G, tid)
template <int MASK, int L, int GR> __device__ __forceinline__ void run_lg(const Params& P, const int wave_s, unsigned char* lds_raw, LAS unsigned char* lds) {
    constexpr int I0 = L * 16 + GR * 8;
    PH_BEGIN(I0 + 0) { const float* xsrc = L == 0 ? inp(P, GR) : (const float*)(P.out + (size_t)GR * GT * DMODEL);
        if (GR == 0 && PHON(9)) ph_wprep(P, bid, G, ws, L, lds, tid);
        if (PHON(0)) ph_p1(bid, G, ws, xsrc, tid); } PH_END
    PH_BEGIN(I0 + 1) if (PHON(1)) {
        pg8::Gemm gm{XB, (const bf16_t*)(ws + WS_W1), 1024, 1024, 1024}; pg8::Order S; S.init(GT, 5632, G, bid, 1, 0);
        { LAS float* rt = (LAS float*)(lds + 139264);
          for (int e = tid; e < 1024; e += NTHR) { const int pos = e >> 4, i = e & 15; const float inv = __builtin_amdgcn_exp2f(-(float)i * (13.287712379549449f / 16.0f)), rev = (float)pos * inv * 0.15915494309189535f; rt[2 * e] = __builtin_amdgcn_cosf(rev); rt[2 * e + 1] = __builtin_amdgcn_sinf(rev); }
          __syncthreads(); }
        pg8::Epi1 E{HB, ssq1, inp(P, I_BGATE) + L * 3072, inp(P, I_QNG) + L * 64, inp(P, I_KNG) + L * 64, (PG8_LAS float*)(lds + 131072), (const PG8_LAS float*)(lds + 139264), (GR == 0 ? 2048 : 4096) - 1};
        pg8::gemm_phase<pg8::Epi1, pg8::Order, true, true>(lds, gm, S, E, tid);
        if (PROBE == 2) { __syncthreads(); pg8::gemm_phase<pg8::Epi1, pg8::Order, true, true>(lds, gm, S, E, tid); } } PH_END
    PH_BEGIN(I0 + 2) if (PHON(2)) { ph_p3a(P, bid, G, ws, L, GR, lds, tid, 1);
        if (PROBE == 6 || PROBE == 10 || PROBE == 11) { constexpr int Q = (L * 2 + GR) * 2; if (PROBE != 6) { BAR2(0); ph_p3a(P, bid, G, ws, L, GR, lds, tid, PROBE == 10 ? 1 : 2); } BAR2(Q + 1); { pg8::Gemm gm{XB, (const bf16_t*)(ws + WS_W1), 1024, 1024, 1024}; pg8::Order S; S.init(GT, 5632, G, bid, 1, 0); pg8::Epi1 E{HB, ssq1, inp(P, I_BGATE) + L * 3072}; pg8::gemm_phase<pg8::Epi1, pg8::Order, true, true>(lds, gm, S, E, tid); } BAR2(Q + 2); ph_p3a(P, bid, G, ws, L, GR, lds, tid); } } PH_END
    PH_BEGIN(I0 + 3) if (PHON(3)) {
        if (PROBE == 12 || PROBE == 13) { ph_p3b(P, bid, G, ws, L, GR, lds_raw, lds, tid, PROBE == 12 ? 1 : 2); BAR2(0); { pg8::Gemm gm{XB, (const bf16_t*)(ws + WS_W1), 1024, 1024, 1024}; pg8::Order S; S.init(GT, 5632, G, bid, 1, 0); pg8::Epi1 E{HB, ssq1, inp(P, I_BGATE) + L * 3072}; pg8::gemm_phase<pg8::Epi1, pg8::Order, true, true>(lds, gm, S, E, tid); } BAR2(0); ph_p3a(P, bid, G, ws, L, GR, lds, tid); BAR2(0); }
        ph_p3b(P, bid, G, ws, L, GR, lds_raw, lds, tid); } PH_END
    PH_BEGIN(I0 + 4) if (PHON(4)) {
        pg8::Gemm gm{HB, (const bf16_t*)(ws + WS_WB), PITCH, 1536, 512}; pg8::Order S; S.init(GT, 1024, G, bid, 3, 512);
        pg8::Epi4 E{HB};
        pg8::gemm_phase<pg8::Epi4, pg8::Order, true, true>(lds, gm, S, E, tid);
        if (PROBE == 4) { __syncthreads(); pg8::gemm_phase<pg8::Epi4, pg8::Order, true, true>(lds, gm, S, E, tid); } } PH_END
    PH_BEGIN(I0 + 5) if (PHON(5)) {
        float* xdst = P.out + (size_t)GR * GT * DMODEL; const float* xsrc = L == 0 ? inp(P, GR) : (const float*)xdst;
        pg8::Gemm gm{HB + COL_MERGED, (const bf16_t*)(ws + WS_WO), PITCH, 1024, 1024}; pg8::Order S; S.init(GT, 1024, G, bid, 1, 0);
        pg8::Epi5 E{xsrc, xdst, XB, ssq2};
        pg8::gemm_phase<pg8::Epi5, pg8::Order, true, true>(lds, gm, S, E, tid); } PH_END
    PH_BEGIN(I0 + 6) if (PHON(6)) {
        pg8::Gemm gm{XB, (const bf16_t*)(ws + WS_WU), 1024, 1024, 1024}; pg8::Order S; S.init_ovl(65, 5632, G, bid);
        pg8::Epi7f E{HB, ssq2, inp(P, I_CW) + (size_t)L * 3 * 5632, inp(P, I_CB) + (size_t)L * 5632, (PG8_LAS float*)(lds + 131072), (GR == 0 ? 2048 : 4096) - 1, GT};
        pg8::gemm_phase<pg8::Epi7f, pg8::Order, true, true>(lds, gm, S, E, tid); } PH_END
    PH_BEGIN(I0 + 7) if (PHON(5)) {
        float* xdst = P.out + (size_t)GR * GT * DMODEL;
        pg8::Gemm gm{HB, (const bf16_t*)(ws + WS_WD), PITCH, 2816, 2816}; pg8::Order S; S.init(GT, 1024, G, bid, 1, 0);
        pg8::Epi5 E{xdst, xdst, nullptr, nullptr};
        pg8::gemm_phase<pg8::Epi5, pg8::Order, true, true>(lds, gm, S, E, tid); } PH_END
}
template <int MASK> __device__ __forceinline__ void fwd_body(const Params& P) {
    extern __shared__ __attribute__((aligned(16))) unsigned char lds_raw[];
    LAS unsigned char* lds = (LAS unsigned char*)lds_raw;
    const int wave_s = __builtin_amdgcn_readfirstlane((int)threadIdx.x >> 6);
    { if (threadIdx.x == 0) { ((volatile LAS unsigned*)(lds + BARST_OFF))[0] = 0u; ((volatile LAS unsigned*)(lds + BARST_OFF))[1] = 0u; (void)xb_add((unsigned*)(P.ws + WS_BAR) + XB_XCNT(xb_xcc_id()), 1u); } __syncthreads(); }
    if (P.hi < 0) { cg::grid_group grid = cg::this_grid(); grid.sync(); }
    run_lg<MASK, 0, 0>(P, wave_s, lds_raw, lds);
    run_lg<MASK, 0, 1>(P, wave_s, lds_raw, lds);
    run_lg<MASK, 1, 0>(P, wave_s, lds_raw, lds);
    run_lg<MASK, 1, 1>(P, wave_s, lds_raw, lds);
    PH_BEGIN(NPH - 1) if (PHON(10)) ph_final(P, bid, G, tid); PH_END
}

#if MK_MULTI
#define DEFK(name, mask) __global__ void __launch_bounds__(NTHR, 2) name(Params P) { fwd_body<mask>(P); }
DEFK(fwd_k0, 0x001) DEFK(fwd_k1, 0x002) DEFK(fwd_k2, 0x004) DEFK(fwd_k3, 0x008) DEFK(fwd_k4, 0x010) DEFK(fwd_k5, 0x020) DEFK(fwd_k6, 0x040) DEFK(fwd_k7, 0x080) DEFK(fwd_k9, 0x200) DEFK(fwd_k10, 0x400)
#define fwd_kernel fwd_k3
#else
__global__ void __launch_bounds__(NTHR, 2) fwd_kernel(Params P) { fwd_body<PH_MASK>(P); }
#endif

extern "C" void kernel_launch(void* const* d_in, const int* in_sizes, int n_in, void* d_out, int out_size, void* d_ws, size_t ws_size, hipStream_t stream) {
    static int grid = 0;
    if (grid == 0) {
        if (n_in != 22 || out_size != 2 * GT * DMODEL || ws_size < WS_END) { fprintf(stderr, "kernel_launch: unexpected shapes (n_in %d out %d ws %zu)\n", n_in, out_size, ws_size); grid = -1; return; }
        int dev = 0, cus = 0, per_cu = 0;
        if (hipGetDevice(&dev) != hipSuccess || hipDeviceGetAttribute(&cus, hipDeviceAttributeMultiprocessorCount, dev) != hipSuccess) { grid = -1; return; }
        if (hipFuncSetAttribute((const void*)fwd_kernel, hipFuncAttributeMaxDynamicSharedMemorySize, LDS_BYTES) != hipSuccess) { fprintf(stderr, "kernel_launch: hipFuncSetAttribute failed\n"); grid = -1; return; }
        if (hipOccupancyMaxActiveBlocksPerMultiprocessor(&per_cu, (const void*)fwd_kernel, NTHR, LDS_BYTES) != hipSuccess || per_cu < 1) { fprintf(stderr, "kernel_launch: occupancy query says %d\n", per_cu); per_cu = 1; }
        (void)hipGetLastError();
        grid = cus;
    }
    if (grid < 0) return;
    (void)hipMemsetAsync((unsigned char*)d_ws + WS_BAR, 0, 16384, stream);
    Params p{};
    for (int i = 0; i < 22; ++i) p.in[i] = (const float*)d_in[i];
    p.out = (float*)d_out; p.ws = (unsigned char*)d_ws;
#if MK_MULTI
    typedef void (*kfn)(Params);
    const kfn kf[11] = {fwd_k0, fwd_k1, fwd_k2, fwd_k3, fwd_k4, fwd_k5, fwd_k6, fwd_k5, fwd_k5, fwd_k9, fwd_k10};
    for (int i = 0; i < 11; ++i) (void)hipFuncSetAttribute((const void*)kf[i], hipFuncAttributeMaxDynamicSharedMemorySize, LDS_BYTES);
    for (int i = 0; i < NPH; ++i) { p.lo = i; p.hi = i + 1;
        const int r = i % 17; const int k = (i == NPH - 1) ? 10 : (r == 0 ? 9 : (r - 1) % 8);
        hipLaunchKernelGGL(kf[k], dim3(grid), dim3(NTHR), LDS_BYTES, stream, p);
        if (PROBE == 8 && k == 3) { for (int d = 2; d >= 0; --d) { p.lo = i - d; p.hi = i - d + 1; hipLaunchKernelGGL(kf[k - d], dim3(grid), dim3(NTHR), LDS_BYTES, stream, p); } } }
#else
    p.lo = 0; p.hi = NPH;
    void* args[] = {&p};
    hipError_t e = hipLaunchCooperativeKernel((const void*)fwd_kernel, dim3(grid), dim3(NTHR), args, LDS_BYTES, stream);
    if (e != hipSuccess) fprintf(stderr, "cooperative launch failed: %s (grid %d)\n", hipGetErrorString(e), grid);
#endif
}
```

```cpp
#include <hip/hip_runtime.h>
#include <hip/hip_cooperative_groups.h>
#include <hip/hip_bf16.h>
#include <cstdio>
#include <cstdint>
#include <cmath>
namespace cg = cooperative_groups;

constexpr int DMODEL = 1024, GT = 16384  , PITCH = 5632  , DFF = 2816;
constexpr int COL_U = 0, COL_QB = 512, COL_QC = 1024, COL_VA = 1536, COL_KB = 2048, COL_VB = 2176, COL_KC = 2304, COL_VC = 2432, COL_MERGED = 1536, COL_GATE = 2560;
constexpr float EPSN = 1e-6f;
constexpr float QK_C2 = 0.125f * 1.4426950408889634f;
__device__ __forceinline__ int otid() { int t = threadIdx.x; asm volatile("" : "+v"(t)); return t; }
__device__ __forceinline__ int obid() { int t = blockIdx.x; asm volatile("" : "+s"(t)); return t; }
__device__ __forceinline__ int ogdim() { int t = gridDim.x; asm volatile("" : "+s"(t)); return t; }

namespace pg8 {
#define PG8_LAS __attribute__((address_space(3)))
typedef unsigned short bf16_t;
typedef short bf16x8 __attribute__((ext_vector_type(8)));
typedef float f32x4 __attribute__((ext_vector_type(4)));
typedef unsigned u32x4 __attribute__((ext_vector_type(4)));
constexpr int BM = 256, BK = 64, HALF = 128, HTB = HALF * BK * 2  , STAGE_BYTES = 8 * HTB, NXCD = 8, WGM = 8;

__host__ __device__ __forceinline__ int lds_byte(int r, int c) { const int st = (r >> 4) * 2 + (c >> 5), rr = r & 15, cc = c & 31, ob = rr * 64 + cc * 2; return st * 1024 + (ob ^ (((ob >> 9) & 1) << 5)); }
__host__ __device__ __forceinline__ void stage_rc(int b, int& R, int& C) { const int st = b / 1024, sb = b % 1024, swz = sb ^ (((sb >> 9) & 1) << 5); R = (st >> 1) * 16 + swz / 64; C = (st & 1) * 32 + (swz % 64) / 2; }
__host__ __device__ __forceinline__ int perm32(int rho) { const int n = rho >> 4, i = rho & 15; return 8 * (i >> 2) + 4 * n + (i & 3); }

struct Unit { int pm, pn, ko, n, arow; };
struct Gemm { const bf16_t* A; const bf16_t* Bt; int lda, ldb, K; };


struct Order {
    int nM, nN, nwg, G, c, rep, kstep, ovl;
    __device__ void init(int M, int N, int G_, int c_, int rep_, int kstep_) { nM = M / BM; nN = N / BM; nwg = nM * nN; G = G_; c = c_; rep = rep_; kstep = kstep_; ovl = 0; }
    __device__ void init_ovl(int nM_, int N, int G_, int c_) { nM = nM_; nN = N / BM; nwg = nM * nN; G = G_; c = c_; rep = 1; kstep = 0; ovl = 1; }
    __device__ bool next(int i, Unit& u) const {
        int ti = i, n = 0; if (rep == 3) { ti = i / 3; n = i - ti * 3; }
        const long L = (long)ti * G + c; if (L >= nwg) return false;
        int wgid = (int)L; { const int q = nwg / NXCD, r = nwg % NXCD, xcd = wgid % NXCD, off = wgid / NXCD; wgid = (xcd < r ? xcd * (q + 1) : r * (q + 1) + (xcd - r) * q) + off; }
        const int nig = WGM * nN, gid = wgid / nig, fm = gid * WGM, gsz = (nM - fm) < WGM ? (nM - fm) : WGM;
        u.pm = fm + ((wgid % nig) % gsz); u.pn = (wgid % nig) / gsz; u.ko = n * kstep; u.n = n; u.arow = ovl ? (u.pm ? 254 * u.pm - 1 : 0) : u.pm * BM; return true;
    }
    __device__ __forceinline__ void a_ready(const Unit&) const {}
    __device__ __forceinline__ void done(const Unit&) const {}
};

__device__ __forceinline__ unsigned cvt_pk_bf16(float lo, float hi) { unsigned r; asm volatile("v_cvt_pk_bf16_f32 %0, %1, %2" : "=v"(r) : "v"(lo), "v"(hi)); return r; }
__device__ __forceinline__ float bf_lo(unsigned w) { return __uint_as_float(w << 16); }
__device__ __forceinline__ float bf_hi(unsigned w) { return __uint_as_float(w & 0xffff0000u); }
__device__ __forceinline__ float sigmoid_f(float v) { return __builtin_amdgcn_rcpf(1.0f + __builtin_amdgcn_exp2f(-1.4426950408889634f * v)); }
__device__ __forceinline__ float gelu_tanh_f(float v) { const float t = v * (1.0f + 0.044715f * v * v); return v * __builtin_amdgcn_rcpf(1.0f + __builtin_amdgcn_exp2f(-2.3022082008f * t)); }
__device__ __forceinline__ float silu_f(float v) { return v * sigmoid_f(v); }
__device__ __forceinline__ u32x4 pack8(f32x4 a, f32x4 b) { u32x4 w; w.x = cvt_pk_bf16(a[0], a[1]); w.y = cvt_pk_bf16(a[2], a[3]); w.z = cvt_pk_bf16(b[0], b[1]); w.w = cvt_pk_bf16(b[2], b[3]); return w; }

struct Epi1 {
    static constexpr bool PERM = true, AFTER_DRAIN = false;
    bf16_t* O; const float* ssq; const float* bgate; const float* qg; const float* kg; PG8_LAS float* xl; const PG8_LAS float* tab; int smask;
    __device__ __forceinline__ void rope_path(const f32x4 (&acc)[2][2][4][2], const Unit& u, int wr, int wc, int fr, int fq, const bool isq) const {
        const int lrow0 = wr * 64 + fr, col0 = u.pn * BM + wc * 32 + 8 * fq;
        float sq[2][4];
#pragma unroll
        for (int ai = 0; ai < 2; ++ai)
#pragma unroll
            for (int m = 0; m < 4; ++m) sq[ai][m] = ssq[u.pm * BM + lrow0 + ai * HALF + m * 16];
        const float* gsrc = (isq ? qg : kg) + 32 * (wc & 1) + 8 * fq;
        const f32x4 g0 = *(const f32x4*)gsrc, g1 = *(const f32x4*)(gsrc + 4);
        const float sc = isq ? QK_C2 : 1.0f;
#pragma unroll
        for (int ai = 0; ai < 2; ++ai)
#pragma unroll
            for (int m = 0; m < 4; ++m) { const float rs2 = 1.0f / (sq[ai][m] * (1.0f / 1024.0f) + EPSN);
#pragma unroll
                for (int bj = 0; bj < 2; ++bj) { if (!isq && bj == 1) continue;
                    const f32x4 a = acc[ai][bj][m][0], b = acc[ai][bj][m][1];
                    float s = ((a[0] * a[0] + a[1] * a[1]) + (a[2] * a[2] + a[3] * a[3])) + ((b[0] * b[0] + b[1] * b[1]) + (b[2] * b[2] + b[3] * b[3]));
                    s += __shfl_xor(s, 16); s += __shfl_xor(s, 32);
                    if (fq == 0) xl[((lrow0 + ai * HALF + m * 16) * 2 + bj) * 4 + wc] = s * rs2; } }
        asm volatile("s_waitcnt lgkmcnt(0)" ::: "memory"); __builtin_amdgcn_s_barrier(); asm volatile("" ::: "memory");
#pragma unroll
        for (int ai = 0; ai < 2; ++ai)
#pragma unroll
            for (int m = 0; m < 4; ++m) {
                const int lrow = lrow0 + ai * HALF + m * 16, grow = u.pm * BM + lrow, t = grow & smask, pos = (wc & 1) ? (t & 63) : (t >> 6);
                const float rs = rsqrtf(sq[ai][m] * (1.0f / 1024.0f) + EPSN);
                const PG8_LAS float* tp = tab + (pos * 16 + 8 * (fq & 1)) * 2;
                const f32x4 c0 = *(const PG8_LAS f32x4*)tp, c1 = *(const PG8_LAS f32x4*)(tp + 4), c2 = *(const PG8_LAS f32x4*)(tp + 8), c3 = *(const PG8_LAS f32x4*)(tp + 12);
                bf16_t* rowp = O + (size_t)grow * PITCH + col0;
#pragma unroll
                for (int bj = 0; bj < 2; ++bj) {
                    if (!isq && bj == 1) { *(u32x4*)(rowp + HALF) = pack8(acc[ai][1][m][0] * rs, acc[ai][1][m][1] * rs); continue; }
                    const PG8_LAS float* xp = xl + ((lrow * 2 + bj) * 4 + (wc & 2));
                    const float hr = rsqrtf((xp[0] + xp[1]) * (1.0f / 64.0f) + EPSN) * rs * sc;
                    f32x4 o0, o1;
#pragma unroll
                    for (int k = 0; k < 8; ++k) {
                        const float y = (k < 4 ? acc[ai][bj][m][0][k & 3] * g0[k & 3] : acc[ai][bj][m][1][k & 3] * g1[k & 3]) * hr;
                        const auto rr = __builtin_amdgcn_permlane32_swap(__float_as_uint(y), __float_as_uint(y), false, false);
                        const float partner = __uint_as_float(fq < 2 ? rr[1] : rr[0]);
                        const f32x4 cs = (k >> 1) == 0 ? c0 : (k >> 1) == 1 ? c1 : (k >> 1) == 2 ? c2 : c3;
                        const float cv = cs[(k & 1) * 2], sv = cs[(k & 1) * 2 + 1];
                        const float r = y * cv + (fq < 2 ? -partner : partner) * sv;
                        if (k < 4) o0[k & 3] = r; else o1[k & 3] = r; }
                    *(u32x4*)(rowp + bj * HALF) = pack8(o0, o1);
                }
            }
    }
    __device__ __forceinline__ void operator()(const f32x4 (&acc)[2][2][4][2], const Unit& u, int wr, int wc, int fr, int fq) const {
        const int row0 = u.pm * BM + wr * 64 + fr, col0 = u.pn * BM + wc * 32 + 8 * fq, pn = u.pn;
        if (pn == 4 || pn == 5 || pn == 9) { rope_path(acc, u, wr, wc, fr, fq, pn != 9); return; }
        const int mode = (pn >= 10) ? 3 : ((pn < 2 || pn == 6 || pn == 7) ? 1 : ((pn == 2 || pn == 3) ? 2 : 0));
        f32x4 bv[2][2];
#pragma unroll
        for (int bj = 0; bj < 2; ++bj)
#pragma unroll
            for (int n = 0; n < 2; ++n) bv[bj][n] = (mode == 3) ? *(const f32x4*)(bgate + (col0 - COL_GATE) + bj * HALF + 4 * n) : (f32x4){0.f, 0.f, 0.f, 0.f};
        float sq[2][4];
#pragma unroll
        for (int ai = 0; ai < 2; ++ai)
#pragma unroll
            for (int m = 0; m < 4; ++m) sq[ai][m] = ssq[row0 + ai * HALF + m * 16];
#pragma unroll
        for (int ai = 0; ai < 2; ++ai)
#pragma unroll
            for (int m = 0; m < 4; ++m) {
                const int row = row0 + ai * HALF + m * 16; const float rs = rsqrtf(sq[ai][m] * (1.0f / 1024.0f) + EPSN);
                bf16_t* rowp = O + (size_t)row * PITCH + col0;
#pragma unroll
                for (int bj = 0; bj < 2; ++bj) {
                    f32x4 v0 = acc[ai][bj][m][0] * rs, v1 = acc[ai][bj][m][1] * rs;
                    if (mode == 1) {
#pragma unroll
                        for (int e = 0; e < 4; ++e) { v0[e] = gelu_tanh_f(v0[e]); v1[e] = gelu_tanh_f(v1[e]); }
                    } else if (mode == 2) { v0 = v0 * QK_C2; v1 = v1 * QK_C2; }
                    else if (mode == 3) { v0 = v0 + bv[bj][0]; v1 = v1 + bv[bj][1];
#pragma unroll
                        for (int e = 0; e < 4; ++e) { v0[e] = sigmoid_f(v0[e]); v1[e] = sigmoid_f(v1[e]); } }
                    *(u32x4*)(rowp + bj * HALF) = pack8(v0, v1);
                }
            }
    }
};

struct Epi4 {
    static constexpr bool PERM = true, AFTER_DRAIN = false;
    bf16_t* HB;
    __device__ __forceinline__ void operator()(const f32x4 (&acc)[2][2][4][2], const Unit& u, int wr, int wc, int fr, int fq) const {
        const int row0 = u.pm * BM + wr * 64 + fr, col0 = u.pn * BM + wc * 32 + 8 * fq;
#pragma unroll
        for (int ai = 0; ai < 2; ++ai) {
            u32x4 gw[4][2], mw[4][2];
#pragma unroll
            for (int m = 0; m < 4; ++m) { const bf16_t* gp = HB + (size_t)(row0 + ai * HALF + m * 16) * PITCH + COL_GATE + u.n * 1024 + col0;
#pragma unroll
                for (int bj = 0; bj < 2; ++bj) gw[m][bj] = *(const u32x4*)(gp + bj * HALF); }
            if (u.n > 0) {
#pragma unroll
                for (int m = 0; m < 4; ++m) { const bf16_t* mp = HB + (size_t)(row0 + ai * HALF + m * 16) * PITCH + COL_MERGED + col0;
#pragma unroll
                    for (int bj = 0; bj < 2; ++bj) mw[m][bj] = *(const u32x4*)(mp + bj * HALF); }
            } else {
#pragma unroll
                for (int m = 0; m < 4; ++m)
#pragma unroll
                    for (int bj = 0; bj < 2; ++bj) mw[m][bj] = (u32x4){0u, 0u, 0u, 0u};
            }
#pragma unroll
            for (int m = 0; m < 4; ++m) { bf16_t* mp = HB + (size_t)(row0 + ai * HALF + m * 16) * PITCH + COL_MERGED + col0;
#pragma unroll
                for (int bj = 0; bj < 2; ++bj) { const u32x4 g = gw[m][bj], w = mw[m][bj];
                    const f32x4 v0 = acc[ai][bj][m][0] * (f32x4){bf_lo(g.x), bf_hi(g.x), bf_lo(g.y), bf_hi(g.y)} + (f32x4){bf_lo(w.x), bf_hi(w.x), bf_lo(w.y), bf_hi(w.y)};
                    const f32x4 v1 = acc[ai][bj][m][1] * (f32x4){bf_lo(g.z), bf_hi(g.z), bf_lo(g.w), bf_hi(g.w)} + (f32x4){bf_lo(w.z), bf_hi(w.z), bf_lo(w.w), bf_hi(w.w)};
                    *(u32x4*)(mp + bj * HALF) = pack8(v0, v1); } }
        }
    }
};

struct Epi5 {
    static constexpr bool PERM = false, AFTER_DRAIN = false;
    const float* xin; float* xout; bf16_t* xb; float* ssq;
    __device__ __forceinline__ void operator()(const f32x4 (&acc)[2][2][4][2], const Unit& u, int wr, int wc, int fr, int fq) const {
        typedef unsigned u32x2v __attribute__((ext_vector_type(2)));
        const int row0 = u.pm * BM + wr * 64 + fr, col0 = u.pn * BM + wc * 32 + 4 * fq;
#pragma unroll
        for (int ai = 0; ai < 2; ++ai) {
            f32x4 xv[4][2][2];
#pragma unroll
            for (int m = 0; m < 4; ++m) { const size_t off = (size_t)(row0 + ai * HALF + m * 16) * DMODEL + col0;
#pragma unroll
                for (int bj = 0; bj < 2; ++bj)
#pragma unroll
                    for (int n = 0; n < 2; ++n) xv[m][bj][n] = *(const f32x4*)(xin + off + bj * HALF + n * 16); }
#pragma unroll
            for (int m = 0; m < 4; ++m) {
                const int row = row0 + ai * HALF + m * 16; const size_t off = (size_t)row * DMODEL + col0; float s = 0.f;
#pragma unroll
                for (int bj = 0; bj < 2; ++bj)
#pragma unroll
                    for (int n = 0; n < 2; ++n) { const size_t c = off + bj * HALF + n * 16; const f32x4 xn = xv[m][bj][n] + acc[ai][bj][m][n]; *(f32x4*)(xout + c) = xn;
                        if (xb) { u32x2v w; w.x = cvt_pk_bf16(xn[0], xn[1]); w.y = cvt_pk_bf16(xn[2], xn[3]); *(u32x2v*)(xb + c) = w; }
                        s += (xn[0] * xn[0] + xn[1] * xn[1]) + (xn[2] * xn[2] + xn[3] * xn[3]); }
                if (ssq) { s += __shfl_xor(s, 16); s += __shfl_xor(s, 32); if (fq == 0) atomicAdd(ssq + row, s); }
            }
        }
    }
};

struct Epi7 {
    static constexpr bool PERM = true, AFTER_DRAIN = false;
    bf16_t* O; const float* ssq; bf16_t* halo;
    __device__ __forceinline__ void operator()(const f32x4 (&acc)[2][2][4][2], const Unit& u, int wr, int wc, int fr, int fq) const {
        const int row0 = u.pm * BM + wr * 64 + fr, col0 = u.pn * BM + wc * 32 + 8 * fq;
#pragma unroll
        for (int ai = 0; ai < 2; ++ai)
#pragma unroll
            for (int m = 0; m < 4; ++m) {
                const int row = row0 + ai * HALF + m * 16; const float rs = rsqrtf(ssq[row] * (1.0f / 1024.0f) + EPSN);
                bf16_t* rowp = O + (size_t)row * PITCH + col0;
                const bool top = (m == 0 && fr == 0), bot = (m == 3 && fr == 15);
                bf16_t* hp = halo + (size_t)((row >> 6) * 2 + (bot ? 1 : 0)) * PITCH + col0;
#pragma unroll
                for (int bj = 0; bj < 2; ++bj) {
                    const u32x4 w = pack8(acc[ai][bj][m][0] * rs, acc[ai][bj][m][1] * rs);
                    *(u32x4*)(rowp + bj * HALF) = w;
                    if (top || bot) *(u32x4*)(hp + bj * HALF) = w;
                }
            }
    }
};

__device__ __forceinline__ float dpp_ror1(float x) { return __int_as_float(__builtin_amdgcn_update_dpp(0, __float_as_int(x), 0x121, 0xf, 0xf, false)); }
__device__ __forceinline__ float dpp_rol1(float x) { return __int_as_float(__builtin_amdgcn_update_dpp(0, __float_as_int(x), 0x12F, 0xf, 0xf, false)); }
struct Epi7f {
    static constexpr bool PERM = true, AFTER_DRAIN = false;
    bf16_t* O; const float* ssq; const float* cw; const float* cb; PG8_LAS float* xl; int smask; int nrows;
    __device__ __forceinline__ void operator()(f32x4 (&acc)[2][2][4][2], const Unit& u, int wr, int wc, int fr, int fq) const {
        typedef unsigned u32x2v __attribute__((ext_vector_type(2)));
        const int lrow0 = wr * 64 + fr, arow = u.arow, olo = u.pm ? 1 : 0;
        float sq[2][4];
#pragma unroll
        for (int ai = 0; ai < 2; ++ai)
#pragma unroll
            for (int m = 0; m < 4; ++m) { int grow = arow + lrow0 + ai * HALF + m * 16; grow = grow < nrows ? grow : nrows - 1; sq[ai][m] = ssq[grow]; }
#pragma unroll
        for (int ai = 0; ai < 2; ++ai)
#pragma unroll
            for (int m = 0; m < 4; ++m) { const float rs = rsqrtf(sq[ai][m] * (1.0f / 1024.0f) + EPSN);
#pragma unroll
                for (int bj = 0; bj < 2; ++bj)
#pragma unroll
                    for (int n = 0; n < 2; ++n) acc[ai][bj][m][n] = acc[ai][bj][m][n] * rs; }
#pragma unroll
        for (int ai = 0; ai < 2; ++ai) { const int blk = 2 * ai + wr;
            if (fr == 15) { PG8_LAS float* p = xl + (((0 * 4 + blk) * 4 + wc) * 4 + fq) * 16;
#pragma unroll
                for (int bj = 0; bj < 2; ++bj)
#pragma unroll
                    for (int n = 0; n < 2; ++n) *(PG8_LAS f32x4*)(p + (bj * 2 + n) * 4) = acc[ai][bj][3][n]; }
            if (fr == 0) { PG8_LAS float* p = xl + (((1 * 4 + blk) * 4 + wc) * 4 + fq) * 16;
#pragma unroll
                for (int bj = 0; bj < 2; ++bj)
#pragma unroll
                    for (int n = 0; n < 2; ++n) *(PG8_LAS f32x4*)(p + (bj * 2 + n) * 4) = acc[ai][bj][0][n]; } }
        asm volatile("s_waitcnt lgkmcnt(0)" ::: "memory"); __builtin_amdgcn_s_barrier(); asm volatile("" ::: "memory");
#pragma unroll
        for (int n = 0; n < 2; ++n) {
            const int cg = u.pn * HALF + wc * 32 + 8 * fq + 4 * n, cv = 2816 + cg;
            const f32x4 wg0 = *(const f32x4*)(cw + cg), wg1 = *(const f32x4*)(cw + 5632 + cg), wg2 = *(const f32x4*)(cw + 2 * 5632 + cg), bg = *(const f32x4*)(cb + cg);
            const f32x4 wv0 = *(const f32x4*)(cw + cv), wv1 = *(const f32x4*)(cw + 5632 + cv), wv2 = *(const f32x4*)(cw + 2 * 5632 + cv), bv = *(const f32x4*)(cb + cv);
#pragma unroll
            for (int ai = 0; ai < 2; ++ai) { const int blk = 2 * ai + wr;
                const PG8_LAS float* pl = xl + (((0 * 4 + (blk > 0 ? blk - 1 : 0)) * 4 + wc) * 4 + fq) * 16;
                const PG8_LAS float* pf = xl + (((1 * 4 + (blk < 3 ? blk + 1 : 3)) * 4 + wc) * 4 + fq) * 16;
#pragma unroll
                for (int m = 0; m < 4; ++m) {
                    const int lrow = lrow0 + ai * HALF + m * 16, grow = arow + lrow;
                    const bool zp = (grow & smask) == 0, zn = ((grow + 1) & smask) == 0;
                    f32x4 hc[2];
#pragma unroll
                    for (int bj = 0; bj < 2; ++bj) {
                        const f32x4 cur = acc[ai][bj][m][n];
                        f32x4 pb, nb;
                        if (m > 0) pb = acc[ai][bj][m - 1][n]; else pb = *(const PG8_LAS f32x4*)(pl + (bj * 2 + n) * 4);
                        if (m < 3) nb = acc[ai][bj][m + 1][n]; else nb = *(const PG8_LAS f32x4*)(pf + (bj * 2 + n) * 4);
                        f32x4 prev, next;
#pragma unroll
                        for (int e = 0; e < 4; ++e) {
                            const float a = dpp_ror1(cur[e]), b = (m > 0) ? dpp_ror1(pb[e]) : pb[e];
                            const float c = dpp_rol1(cur[e]), d = (m < 3) ? dpp_rol1(nb[e]) : nb[e];
                            prev[e] = zp ? 0.f : (fr == 0 ? b : a); next[e] = zn ? 0.f : (fr == 15 ? d : c); }
                        hc[bj] = bj == 0 ? prev * wg0 + cur * wg1 + next * wg2 + bg : prev * wv0 + cur * wv1 + next * wv2 + bv;
                    }
                    if (lrow >= olo && lrow <= olo + 253 && grow < nrows) {
                        u32x2v w; w.x = cvt_pk_bf16(silu_f(hc[0][0]) * hc[1][0], silu_f(hc[0][1]) * hc[1][1]); w.y = cvt_pk_bf16(silu_f(hc[0][2]) * hc[1][2], silu_f(hc[0][3]) * hc[1][3]);
                        *(u32x2v*)(O + (size_t)grow * PITCH + cg) = w; }
                }
            }
        }
    }
};

template <class Epi, class Sched, bool ALIGN_EPI = false, bool SP2 = false>
__device__ __forceinline__ void gemm_phase(PG8_LAS unsigned char* lds, const Gemm g, const Sched& S, const Epi& E, const int tid_in) {
    int tid = tid_in; asm volatile("" : "+v"(tid)); const int wid = __builtin_amdgcn_readfirstlane(tid >> 6), lane = tid & 63, wr = wid >> 2, wc = wid & 3, fr = lane & 15, fq = lane >> 4;
    const int K = g.K, nt = K / BK;
    unsigned voffA[2], voffB[2];
#pragma unroll
    for (int i = 0; i < 2; ++i) { int R, C; stage_rc(tid * 16 + i * 8192, R, C); const int Rb = Epi::PERM ? ((R & ~31) + perm32(R & 31)) : R;
        voffA[i] = (unsigned)(R * g.lda + C) * 2u; voffB[i] = (unsigned)(Rb * g.ldb + C) * 2u; }
    const size_t kstep = (size_t)(BK * 2);
    const size_t hstepA = (size_t)HALF * g.lda * 2, hstepB = (size_t)HALF * g.ldb * 2;
    const size_t tstepB = 2 * hstepB;
    const unsigned ldsw = (unsigned)wid * 1024u;
    const int aoff = lds_byte(wr * 64 + fr, fq * 8), boff = lds_byte(wc * 32 + fr, fq * 8);
#define PG8_SA(b, h) (((b) * 2 + (h)) * HTB)
#define PG8_SB(b, h) ((4 + (b) * 2 + (h)) * HTB)
#define PG8_STAGE(bufoff, gbase, voff) do { _Pragma("unroll") for (int _i = 0; _i < 2; ++_i) \
        __builtin_amdgcn_global_load_lds((const unsigned*)((const char*)(gbase) + (voff)[_i]), (PG8_LAS unsigned*)(lds + (bufoff) + ldsw + _i * 8192), 16, 0, 0); } while (0)
#define PG8_LDA(dst, b, h) do { _Pragma("unroll") for (int m = 0; m < 4; ++m) _Pragma("unroll") for (int k = 0; k < 2; ++k) dst[m][k] = *(const PG8_LAS bf16x8*)(lds + PG8_SA(b, h) + aoff + m * 2048 + k * 1024); } while (0)
#define PG8_LDB(dst, b, h) do { _Pragma("unroll") for (int n = 0; n < 2; ++n) _Pragma("unroll") for (int k = 0; k < 2; ++k) dst[n][k] = *(const PG8_LAS bf16x8*)(lds + PG8_SB(b, h) + boff + n * 2048 + k * 1024); } while (0)
#define PG8_MMA(ai, bj, At, Bt) do { __builtin_amdgcn_s_setprio(1); _Pragma("unroll") for (int m = 0; m < 4; ++m) _Pragma("unroll") for (int n = 0; n < 2; ++n) _Pragma("unroll") for (int k = 0; k < 2; ++k) \
        acc[ai][bj][m][n] = __builtin_amdgcn_mfma_f32_16x16x32_bf16(Bt[n][k], At[m][k], acc[ai][bj][m][n], 0, 0, 0); __builtin_amdgcn_s_setprio(0); } while (0)
#define PG8_WAIT_V(n) asm volatile("s_waitcnt vmcnt(" #n ")" ::: "memory")
#define PG8_WAIT_L(n) asm volatile("s_waitcnt lgkmcnt(" #n ")" ::: "memory")
#define PG8_BAR __builtin_amdgcn_s_barrier()
#define PG8_SCHED __builtin_amdgcn_sched_barrier(0)
    Unit cur, nxt; int ui = 0;
    if (!S.next(0, cur)) return;
    f32x4 acc[2][2][4][2];
#pragma unroll
    for (int a = 0; a < 2; ++a)
#pragma unroll
        for (int b = 0; b < 2; ++b)
#pragma unroll
            for (int m = 0; m < 4; ++m)
#pragma unroll
                for (int n = 0; n < 2; ++n) acc[a][b][m][n] = (f32x4){0.f, 0.f, 0.f, 0.f};
    bf16x8 At[4][2], B0[2][2], B1[2][2];
    const char* cA = (const char*)g.A + (size_t)cur.arow * (size_t)g.lda * 2 + (size_t)cur.ko * 2; const char* cB = (const char*)g.Bt + (size_t)cur.pn * tstepB + (size_t)cur.ko * 2;
    S.a_ready(cur);
    if constexpr (SP2) {
        PG8_STAGE(PG8_SB(0, 0), cB, voffB); PG8_STAGE(PG8_SB(0, 1), cB + hstepB, voffB); PG8_STAGE(PG8_SA(0, 0), cA, voffA); PG8_STAGE(PG8_SA(0, 1), cA + hstepA, voffA);
        if (wr == 1) PG8_BAR;
        PG8_WAIT_V(2); PG8_BAR;
        PG8_STAGE(PG8_SB(1, 0), cB + kstep, voffB); PG8_STAGE(PG8_SA(1, 0), cA + kstep, voffA); PG8_STAGE(PG8_SB(1, 1), cB + hstepB + kstep, voffB);
        PG8_WAIT_V(6); PG8_BAR;
    } else {
        PG8_STAGE(PG8_SB(0, 0), cB, voffB); PG8_STAGE(PG8_SA(0, 0), cA, voffA); PG8_STAGE(PG8_SB(0, 1), cB + hstepB, voffB); PG8_STAGE(PG8_SA(0, 1), cA + hstepA, voffA);
        if (wr == 1) PG8_BAR;
        PG8_WAIT_V(4); PG8_BAR;
        PG8_STAGE(PG8_SB(1, 0), cB + kstep, voffB); PG8_STAGE(PG8_SA(1, 0), cA + kstep, voffA); PG8_STAGE(PG8_SB(1, 1), cB + hstepB + kstep, voffB);
        PG8_WAIT_V(6); PG8_BAR;
    }
    for (;;) {
        const bool has_next = S.next(ui + 1, nxt);
        const char* nA = has_next ? (const char*)g.A + (size_t)nxt.arow * (size_t)g.lda * 2 + (size_t)nxt.ko * 2 : cA; const char* nB = has_next ? (const char*)g.Bt + (size_t)nxt.pn * tstepB + (size_t)nxt.ko * 2 : cB;
        for (int t = 0; t < nt; t += 2) {
            const bool last = (t == nt - 2);
            const char* a1 = cA + (size_t)(t + 1) * kstep;
            const char* a2 = last ? nA : cA + (size_t)(t + 2) * kstep; const char* b2 = last ? nB : cB + (size_t)(t + 2) * kstep;
            const char* a3 = a2 + kstep; const char* b3 = b2 + kstep;
            if (last && has_next) S.a_ready(nxt);
            if constexpr (SP2) {
            PG8_LDB(B0, 0, 0); PG8_LDB(B1, 0, 1); PG8_SCHED; PG8_LDA(At, 0, 0); PG8_STAGE(PG8_SA(1, 1), a1 + hstepA, voffA);
            PG8_WAIT_V(8); PG8_WAIT_L(0); PG8_BAR; PG8_MMA(0, 0, At, B0); PG8_MMA(0, 1, At, B1); PG8_BAR; PG8_SCHED;
            PG8_LDA(At, 0, 1); PG8_STAGE(PG8_SB(0, 0), b2, voffB); PG8_STAGE(PG8_SB(0, 1), b2 + hstepB, voffB); PG8_STAGE(PG8_SA(0, 0), a2, voffA);
            PG8_WAIT_V(8); PG8_WAIT_L(0); PG8_BAR; PG8_MMA(1, 0, At, B0); PG8_MMA(1, 1, At, B1); PG8_BAR; PG8_SCHED;
            PG8_LDB(B0, 1, 0); PG8_LDB(B1, 1, 1); PG8_SCHED; PG8_LDA(At, 1, 0); PG8_STAGE(PG8_SA(0, 1), a2 + hstepA, voffA);
            PG8_WAIT_V(8); PG8_WAIT_L(0); PG8_BAR; PG8_MMA(0, 0, At, B0); PG8_MMA(0, 1, At, B1); PG8_BAR; PG8_SCHED;
            PG8_LDA(At, 1, 1); PG8_STAGE(PG8_SB(1, 0), b3, voffB); PG8_STAGE(PG8_SB(1, 1), b3 + hstepB, voffB); PG8_STAGE(PG8_SA(1, 0), a3, voffA);
            PG8_WAIT_V(8); PG8_WAIT_L(0); PG8_BAR; PG8_MMA(1, 0, At, B0); PG8_MMA(1, 1, At, B1); PG8_BAR; PG8_SCHED;
            } else {
            PG8_LDB(B0, 0, 0); PG8_SCHED; PG8_LDA(At, 0, 0); PG8_STAGE(PG8_SA(1, 1), a1 + hstepA, voffA);
            PG8_WAIT_L(8); PG8_BAR; PG8_WAIT_L(0); PG8_MMA(0, 0, At, B0); PG8_BAR; PG8_SCHED;
            PG8_LDB(B1, 0, 1); PG8_STAGE(PG8_SB(0, 0), b2, voffB);
            PG8_BAR; PG8_WAIT_L(0); PG8_MMA(0, 1, At, B1); PG8_BAR;
            PG8_LDA(At, 0, 1); PG8_STAGE(PG8_SA(0, 0), a2, voffA);
            PG8_BAR; PG8_WAIT_L(0); PG8_MMA(1, 0, At, B0); PG8_BAR; PG8_SCHED;
            PG8_STAGE(PG8_SB(0, 1), b2 + hstepB, voffB);
            PG8_WAIT_V(6); PG8_BAR; PG8_MMA(1, 1, At, B1); PG8_BAR;
            PG8_LDB(B0, 1, 0); PG8_SCHED; PG8_LDA(At, 1, 0); PG8_STAGE(PG8_SA(0, 1), a2 + hstepA, voffA);
            PG8_WAIT_L(8); PG8_BAR; PG8_WAIT_L(0); PG8_MMA(0, 0, At, B0); PG8_BAR; PG8_SCHED;
            PG8_LDB(B1, 1, 1); PG8_STAGE(PG8_SB(1, 0), b3, voffB);
            PG8_BAR; PG8_WAIT_L(0); PG8_MMA(0, 1, At, B1); PG8_BAR;
            PG8_LDA(At, 1, 1); PG8_STAGE(PG8_SA(1, 0), a3, voffA);
            PG8_BAR; PG8_WAIT_L(0); PG8_MMA(1, 0, At, B0); PG8_BAR; PG8_SCHED;
            PG8_STAGE(PG8_SB(1, 1), b3 + hstepB, voffB);
            PG8_WAIT_V(6); PG8_BAR; PG8_MMA(1, 1, At, B1); PG8_BAR;
            }
        }
        if constexpr (ALIGN_EPI) { if (wr == 0) PG8_BAR; }
        if constexpr (!Epi::AFTER_DRAIN) { E(acc, cur, wr, wc, fr, fq); S.done(cur); }
        if (!has_next) break;
#pragma unroll
        for (int a = 0; a < 2; ++a)
#pragma unroll
            for (int b = 0; b < 2; ++b)
#pragma unroll
                for (int m = 0; m < 4; ++m)
#pragma unroll
                    for (int n = 0; n < 2; ++n) acc[a][b][m][n] = (f32x4){0.f, 0.f, 0.f, 0.f};
        cur = nxt; cA = nA; cB = nB; ++ui;
        if constexpr (ALIGN_EPI) { if (wr == 1) PG8_BAR; }
    }
    PG8_WAIT_V(0);
    if constexpr (!ALIGN_EPI) { if (wr == 0) PG8_BAR; }
    PG8_BAR;
    if constexpr (Epi::AFTER_DRAIN) { E.fused(acc, cur, wr, wc, fr, fq, lds, wid, lane); S.done(cur); }
#undef PG8_SA
#undef PG8_SB
#undef PG8_STAGE
#undef PG8_LDA
#undef PG8_LDB
#undef PG8_MMA
#undef PG8_WAIT_V
#undef PG8_WAIT_L
#undef PG8_BAR
#undef PG8_SCHED
}
}
namespace attn_body {
using bf16=__hip_bfloat16;
using bf16x8=__attribute__((ext_vector_type(8)))short;
using s16x4=__attribute__((ext_vector_type(4)))short;
using f32x16=__attribute__((ext_vector_type(16)))float;
using u32x4=__attribute__((ext_vector_type(4)))unsigned;
constexpr int D=64,DM=5632;
constexpr int NW=8,QBLK=32,QB=QBLK*NW,KVBLK=64;
constexpr int ATTN_PITCH=DM, ATTN_UNIT_ROWS=QB;
__device__ __forceinline__ int crow(int r,int hi){return (r&3)+8*(r>>2)+4*hi;}
#define SBAR() __builtin_amdgcn_sched_barrier(0)
__device__ __forceinline__ void cmask(f32x16&p0,f32x16&p1,int jb,int qrel,int hi){
  const float NEG=-INFINITY; int kb=64*jb+4*hi;
  #pragma unroll
  for(int r=0;r<16;++r){int kv=kb+(r&3)+8*(r>>2); if(kv>qrel)p0[r]=NEG; if(kv+32>qrel)p1[r]=NEG;}
}

typedef __attribute__((address_space(3))) const float* lds_fptr;
__device__ __forceinline__ void bmask(f32x16&p0,f32x16&p1,int rel0,lds_fptr tab){
  float bb[16];
  #pragma unroll
  for(int r=0;r<16;++r){ const int rel=rel0+(r&3)+8*(r>>2); bb[r]=tab[min(max(rel+128,0),256)]; }
  __builtin_amdgcn_sched_barrier(0);
  #pragma unroll
  for(int r=0;r<16;++r){ const int rel=rel0+(r&3)+8*(r>>2); p0[r]=((unsigned)(rel+128)<=256u)?p0[r]+bb[r]:-1000.f; }
  __builtin_amdgcn_sched_barrier(0);
  #pragma unroll
  for(int r=0;r<16;++r){ const int rel=rel0+32+(r&3)+8*(r>>2); bb[r]=tab[min(max(rel+128,0),256)]; }
  __builtin_amdgcn_sched_barrier(0);
  #pragma unroll
  for(int r=0;r<16;++r){ const int rel=rel0+32+(r&3)+8*(r>>2); p1[r]=((unsigned)(rel+128)<=256u)?p1[r]+bb[r]:-1000.f; }
}
constexpr int NSLOT=3, SLOTB=8192;
constexpr int LDS_K=0, LDS_V=NSLOT*SLOTB, LDS_WS=2*NSLOT*SLOTB, LDS_OST=LDS_WS+NW*64*4, LDS_BYTES=LDS_OST+NW*4096;
constexpr float C2=0.125f*1.4426950408889634f;
__device__ __forceinline__ void glds16(const void*gsrc,unsigned lds_dst){unsigned keep;
  asm volatile("s_mov_b32 %0, m0\n\ts_mov_b32 m0, %2\n\ts_nop 0\n\tglobal_load_lds_dwordx4 %1, off\n\ts_mov_b32 m0, %0":"=&s"(keep):"v"(gsrc),"s"(lds_dst):"memory");}
__device__ __forceinline__ float max3f(float a,float b,float c){float r;asm("v_max3_f32 %0, %1, %2, %3":"=v"(r):"v"(a),"v"(b),"v"(c));return r;}
__device__ __forceinline__ float max2f(float a,float b){float r;asm("v_max_f32_e32 %0, %1, %2":"=v"(r):"v"(a),"v"(b));return r;}
__device__ __forceinline__ float fadd_s(float a,float b){float r;asm("v_add_f32_e32 %0, %1, %2":"=v"(r):"v"(a),"v"(b));return r;}
__device__ __forceinline__ float fsub_s(float a,float b){float r;asm("v_sub_f32_e32 %0, %1, %2":"=v"(r):"v"(a),"v"(b));return r;}
typedef float f32x2_t __attribute__((ext_vector_type(2))); typedef __bf16 bf16x2_t __attribute__((ext_vector_type(2)));
__device__ __forceinline__ unsigned cvtpk_s(float lo,float hi){f32x2_t v={lo,hi};bf16x2_t b=__builtin_convertvector(v,bf16x2_t);return __builtin_bit_cast(unsigned,b);}
#define WAIT_BAR(N) asm volatile("s_waitcnt vmcnt(" #N ") lgkmcnt(0)\n\ts_barrier":::"memory")

__device__ __forceinline__ void qkt(f32x16&p0,f32x16&p1,const char*Kslot,const bf16x8*qr,const f32x16&negm,int r32,int hi){
  const char*kb=Kslot+hi*1024+r32*16;
  #pragma unroll
  for(int d0=0;d0<4;++d0){
    const bf16x8 b0=*reinterpret_cast<const bf16x8*>(kb+d0*2048);
    const bf16x8 b1=*reinterpret_cast<const bf16x8*>(kb+d0*2048+512);
    if(d0==0){p0=__builtin_amdgcn_mfma_f32_32x32x16_bf16(b0,qr[0],negm,0,0,0);p1=__builtin_amdgcn_mfma_f32_32x32x16_bf16(b1,qr[0],negm,0,0,0);}
    else{p0=__builtin_amdgcn_mfma_f32_32x32x16_bf16(b0,qr[d0],p0,0,0,0);p1=__builtin_amdgcn_mfma_f32_32x32x16_bf16(b1,qr[d0],p1,0,0,0);}}
}
typedef __attribute__((address_space(3))) const char* lds_cptr;
typedef short v4i16_t __attribute__((ext_vector_type(4)));
__device__ __forceinline__ void kload8(bf16x8*kf,lds_cptr kp){
  kf[0]=*(const __attribute__((address_space(3))) bf16x8*)(kp);      kf[1]=*(const __attribute__((address_space(3))) bf16x8*)(kp+512);
  kf[2]=*(const __attribute__((address_space(3))) bf16x8*)(kp+2048); kf[3]=*(const __attribute__((address_space(3))) bf16x8*)(kp+2560);
  kf[4]=*(const __attribute__((address_space(3))) bf16x8*)(kp+4096); kf[5]=*(const __attribute__((address_space(3))) bf16x8*)(kp+4608);
  kf[6]=*(const __attribute__((address_space(3))) bf16x8*)(kp+6144); kf[7]=*(const __attribute__((address_space(3))) bf16x8*)(kp+6656);
}
__device__ __forceinline__ void kload2(bf16x8*kf,lds_cptr kp,int j){ kf[2*j]=*(const __attribute__((address_space(3))) bf16x8*)(kp+j*2048); kf[2*j+1]=*(const __attribute__((address_space(3))) bf16x8*)(kp+j*2048+512); }
__device__ __forceinline__ s16x4 vtr(lds_cptr p){ return __builtin_bit_cast(s16x4,__builtin_amdgcn_ds_read_tr16_b64_v4i16((__attribute__((address_space(3))) v4i16_t*)p)); }
__device__ __forceinline__ float rowmax(const f32x16&p0,const f32x16&p1){
  float a=max3f(p0[0],p0[1],p1[0]),b=max3f(p0[2],p0[3],p1[1]);a=max3f(a,p1[2],p1[3]);
  #pragma unroll
  for(int r=4;r<16;r+=4){a=max3f(a,p0[r],p0[r+1]);b=max3f(b,p0[r+2],p0[r+3]);a=max3f(a,p1[r],p1[r+1]);b=max3f(b,p1[r+2],p1[r+3]);}
  const float m=max2f(a,b);
  auto rr=__builtin_amdgcn_permlane32_swap(__float_as_uint(m),__float_as_uint(m),false,false);
  return max2f(__uint_as_float(rr[0]),__uint_as_float(rr[1]));
}
__device__ __forceinline__ void pv(f32x16*o,int vb,bf16x8 pa0,bf16x8 pa1,bf16x8 pa2,bf16x8 pa3){
  #pragma unroll
  for(int d0=0;d0<2;++d0){s16x4 lo[4],hi[4];
    #pragma unroll
    for(int ks=0;ks<4;++ks){
      asm volatile("ds_read_b64_tr_b16 %0,%1 offset:%c2":"=&v"(lo[ks]):"v"(vb),"i"(d0*4096+ks*1024):"memory");
      asm volatile("ds_read_b64_tr_b16 %0,%1 offset:%c2":"=&v"(hi[ks]):"v"(vb),"i"(d0*4096+ks*1024+512):"memory");}
    asm volatile("s_waitcnt lgkmcnt(0)":::"memory");SBAR();
    #define PK(k) (bf16x8){lo[k][0],lo[k][1],lo[k][2],lo[k][3],hi[k][0],hi[k][1],hi[k][2],hi[k][3]}
    o[d0]=__builtin_amdgcn_mfma_f32_32x32x16_bf16(pa0,PK(0),o[d0],0,0,0);
    o[d0]=__builtin_amdgcn_mfma_f32_32x32x16_bf16(pa1,PK(1),o[d0],0,0,0);
    o[d0]=__builtin_amdgcn_mfma_f32_32x32x16_bf16(pa2,PK(2),o[d0],0,0,0);
    o[d0]=__builtin_amdgcn_mfma_f32_32x32x16_bf16(pa3,PK(3),o[d0],0,0,0);
    #undef PK
  }
}

#ifndef ATTN_STORE16
#define ATTN_STORE16(p,v) (*(u32x4*)(p)=(v))
#endif
template<int THRL,int MODE> __device__ __forceinline__ void attn_unit(long rowbase,int q0,int kt0,int NT,const bf16*Q,const bf16*__restrict__ K,const bf16*__restrict__ V,bf16*O,char*shm,lds_fptr btab,float sinkl2,const int tid_in){
  int tid=tid_in; asm volatile("":"+v"(tid)); const int lane=tid&63,r32=lane&31,hi=lane>>5; const int wid=__builtin_amdgcn_readfirstlane(tid>>6);
    const bf16*Qw=Q+(rowbase+q0+wid*QBLK)*DM;
  const bf16*Kh=K+(rowbase+kt0)*DM,*Vh=V+(rowbase+kt0)*DM;
  const unsigned lds0=(unsigned)(uintptr_t)shm;
  float*wsf=(float*)(shm+LDS_WS)+wid*64;
  const bf16*ksrc=Kh+(long)lane*DM+wid*8;
  const bf16*vsrc=Vh+(long)(16*(wid&3)+(lane>>2))*DM+(wid>>2)*32+(lane&3)*8;
  const unsigned kdst=lds0+LDS_K+wid*1024, vdst=lds0+LDS_V+wid*1024;
  #define DMA_K(t,slot) glds16(ksrc+(long)(t)*KVBLK*DM,(unsigned)__builtin_amdgcn_readfirstlane(kdst+(slot)))
  #define DMA_V(t,slot) glds16(vsrc+(long)(t)*KVBLK*DM,(unsigned)__builtin_amdgcn_readfirstlane(vdst+(slot)))
  const int vb0=(int)(lds0+LDS_V)+((lane>>4)&1)*32+(lane&3)*8+(4*hi+((lane&15)>>2))*64;
  const char*Kbase=shm+LDS_K; bf16x8 kf[8];
  const lds_cptr shm3=(lds_cptr)shm; const lds_cptr kp0=shm3+LDS_K+hi*1024+r32*16; const lds_cptr vp0=shm3+LDS_V+((lane>>4)&1)*32+(lane&3)*8+(4*hi+((lane&15)>>2))*64;
  DMA_K(0,0);DMA_V(0,0);DMA_K(1,SLOTB);
  bf16x8 qr[4];
  #pragma unroll
  for(int d0=0;d0<4;++d0)qr[d0]=*reinterpret_cast<const bf16x8*>(&Qw[(long)r32*DM+d0*16+hi*8]);
  float mhat=0.f,l_reg=0.f;f32x16 o[2];o[0]=f32x16{};o[1]=f32x16{};f32x16 negm=f32x16{};asm volatile("":"+v"(negm));
  const int qrel=wid*QBLK+r32;
  #define CMASK(P0,P1,t) do{ if(MODE==1) bmask(P0,P1,kt0+64*(t)+4*hi-(q0+qrel),btab); }while(0)
  bool resc=false;
  #define START(P0,P1) do{ const float rm=rowmax(P0,P1); resc=false; \
    { const float dl=rm; mhat=fadd_s(mhat,dl); \
      _Pragma("unroll") for(int r=0;r<16;++r){P0[r]=fsub_s(P0[r],dl);P1[r]=fsub_s(P1[r],dl);} \
      _Pragma("unroll") for(int r=0;r<16;++r)negm[r]=-mhat; asm volatile("":"+v"(negm)); } \
    _Pragma("unroll") for(int r=0;r<16;++r)P0[r]=__builtin_amdgcn_exp2f(P0[r]); }while(0)
  #define RESC() do{ if(resc){ asm volatile("s_waitcnt lgkmcnt(0)":::"memory"); \
      _Pragma("unroll") for(int d_=0;d_<2;++d_) _Pragma("unroll") for(int r=0;r<16;++r)o[d_][r]*=wsf[crow(r,hi)]; } }while(0)
  f32x16 pA0,pA1,pB0,pB1;
  int sl_prev=0,sl_cur=0,sl_next=SLOTB;
  #define ROT() do{sl_prev=sl_cur;sl_cur=sl_next;sl_next=(sl_next==(NSLOT-1)*SLOTB)?0:sl_next+SLOTB;}while(0)
  DMA_K(2,2*SLOTB);
  WAIT_BAR(3);
  qkt(pA0,pA1,Kbase,qr,negm,r32,hi);asm volatile("s_nop 15\n\ts_nop 7":"+v"(pA0),"+v"(pA1));CMASK(pA0,pA1,0);
  START(pA0,pA1);
  _Pragma("unroll") for(int r=0;r<16;++r)pA1[r]=__builtin_amdgcn_exp2f(pA1[r]);
  WAIT_BAR(0);
  DMA_K(3,0);DMA_V(1,SLOTB);
  ROT();
  kload8(kf,kp0+sl_cur);
  WAIT_BAR(2);
  s16x4 vlo[8],vhi[8]; u32x4 pw0,pw1,pw2,pw3;
  #define PKW(P,B) cvtpk_s(P[B],P[B+1])
  #define PAF(k) __builtin_bit_cast(bf16x8,pw##k)
  #define VFR(i) (bf16x8){vlo[i][0],vlo[i][1],vlo[i][2],vlo[i][3],vhi[i][0],vhi[i][1],vhi[i][2],vhi[i][3]}
  #define PIN(x) asm volatile("":"+v"(x))
  #define MX3(a,b,c) __builtin_fmaxf(__builtin_fmaxf((a),(b)),(c))
  #define GAPA(MF,A0,A1,A2,A3,W0,W1,PW) do{ MF; sacc+=A0; sacc+=A1; sacc+=A2; sacc+=A3; PIN(sacc); W0; W1; PIN(PW); SBAR(); }while(0)
  #define EX(v) __builtin_amdgcn_exp2f(v)
  #define GAPB(MF,X,B) do{ MF; X[B]=EX(X[B]); X[B+1]=EX(X[B+1]); X[B+2]=EX(X[B+2]); X[B+3]=EX(X[B+3]); PIN(X); SBAR(); }while(0)
  #define VRD(i) do{ vlo[i]=vtr(vp_+(((i)>>2)*4096+((i)&3)*1024)); vhi[i]=vtr(vp_+(((i)>>2)*4096+((i)&3)*1024+512)); }while(0)
  #define KRD(G,j) do{ if(G){ kload2(kf,kp0+sl_next,j); SBAR(); } }while(0)
  #define STEP(C0,C1,P0,P1,t,GK,GV,GL) do{ SBAR(); \
    const lds_cptr vp_=vp0+sl_prev; \
    VRD(0); SBAR(); float sacc=(P0[0]+P0[1]); \
    GAPA(C0=__builtin_amdgcn_mfma_f32_32x32x16_bf16(kf[0],qr[0],negm,0,0,0), P0[2],P0[3],P0[4],P0[5],     pw0[0]=PKW(P0,0), pw0[1]=PKW(P0,2), pw0); \
    VRD(4); SBAR(); GAPA(C1=__builtin_amdgcn_mfma_f32_32x32x16_bf16(kf[1],qr[0],negm,0,0,0), P0[6],P0[7],P0[8],P0[9],     pw0[2]=PKW(P0,4), pw0[3]=PKW(P0,6), pw0); \
    VRD(1); SBAR(); GAPA(C0=__builtin_amdgcn_mfma_f32_32x32x16_bf16(kf[2],qr[1],C0,0,0,0),   P0[10],P0[11],P0[12],P0[13], pw1[0]=PKW(P0,8), pw1[1]=PKW(P0,10), pw1); \
    VRD(5); SBAR(); GAPA(C1=__builtin_amdgcn_mfma_f32_32x32x16_bf16(kf[3],qr[1],C1,0,0,0),   P0[14],P0[15],P1[0],P1[1],   pw1[2]=PKW(P0,12),pw1[3]=PKW(P0,14), pw1); \
    VRD(2); SBAR(); GAPA(C0=__builtin_amdgcn_mfma_f32_32x32x16_bf16(kf[4],qr[2],C0,0,0,0),   P1[2],P1[3],P1[4],P1[5],     pw2[0]=PKW(P1,0), pw2[1]=PKW(P1,2), pw2); \
    VRD(6); SBAR(); GAPA(C1=__builtin_amdgcn_mfma_f32_32x32x16_bf16(kf[5],qr[2],C1,0,0,0),   P1[6],P1[7],P1[8],P1[9],     pw2[2]=PKW(P1,4), pw2[3]=PKW(P1,6), pw2); \
    VRD(3); SBAR(); GAPA(C0=__builtin_amdgcn_mfma_f32_32x32x16_bf16(kf[6],qr[3],C0,0,0,0),   P1[10],P1[11],P1[12],P1[13], pw3[0]=PKW(P1,8), pw3[1]=PKW(P1,10), pw3); \
    VRD(7); SBAR(); GAPA(C1=__builtin_amdgcn_mfma_f32_32x32x16_bf16(kf[7],qr[3],C1,0,0,0),   P1[14],P1[15],0.f,0.f,       pw3[2]=PKW(P1,12),pw3[3]=PKW(P1,14), pw3); \
    l_reg+=sacc; \
    if(GK){DMA_K((t)+3,sl_cur);} if(GV){DMA_V((t)+1,sl_next);} \
    CMASK(C0,C1,t); \
    { float a=MX3(C0[0],C0[1],C1[0]),b=MX3(C0[2],C0[3],C1[1]); a=MX3(a,C1[2],C1[3]); \
      _Pragma("unroll") for(int r=4;r<16;r+=4){a=MX3(a,C0[r],C0[r+1]);b=MX3(b,C0[r+2],C0[r+3]);a=MX3(a,C1[r],C1[r+1]);b=MX3(b,C1[r+2],C1[r+3]);} \
      float rm=__builtin_fmaxf(a,b); { auto rr=__builtin_amdgcn_permlane32_swap(__float_as_uint(rm),__float_as_uint(rm),false,false); rm=__builtin_fmaxf(__uint_as_float(rr[0]),__uint_as_float(rr[1])); } \
      resc=false; \
      if(__builtin_expect(__any(rm>(float)THRL),0)){ const float dl=__builtin_fmaxf(rm,0.f); mhat+=dl; \
        _Pragma("unroll") for(int r=0;r<16;++r){C0[r]-=dl;C1[r]-=dl;} \
        _Pragma("unroll") for(int r=0;r<16;++r)negm[r]=-mhat; asm volatile("":"+v"(negm)); \
        const float f=__builtin_amdgcn_exp2f(-dl); l_reg*=f; if(hi==0)wsf[r32]=f; resc=true; } } \
    SBAR(); \
    GAPB(o[0]=__builtin_amdgcn_mfma_f32_32x32x16_bf16(PAF(0),VFR(0),o[0],0,0,0), C0,0); \
    GAPB(o[1]=__builtin_amdgcn_mfma_f32_32x32x16_bf16(PAF(0),VFR(4),o[1],0,0,0), C0,4); \
    KRD(GL,0); GAPB(o[0]=__builtin_amdgcn_mfma_f32_32x32x16_bf16(PAF(1),VFR(1),o[0],0,0,0), C0,8); \
    KRD(GL,1); GAPB(o[1]=__builtin_amdgcn_mfma_f32_32x32x16_bf16(PAF(1),VFR(5),o[1],0,0,0), C0,12); \
    KRD(GL,2); GAPB(o[0]=__builtin_amdgcn_mfma_f32_32x32x16_bf16(PAF(2),VFR(2),o[0],0,0,0), C1,0); \
    KRD(GL,3); GAPB(o[1]=__builtin_amdgcn_mfma_f32_32x32x16_bf16(PAF(2),VFR(6),o[1],0,0,0), C1,4); \
    GAPB(o[0]=__builtin_amdgcn_mfma_f32_32x32x16_bf16(PAF(3),VFR(3),o[0],0,0,0), C1,8); \
    GAPB(o[1]=__builtin_amdgcn_mfma_f32_32x32x16_bf16(PAF(3),VFR(7),o[1],0,0,0), C1,12); \
    }while(0)
  int t=1;
  for(;t+5<NT;t+=2){
    STEP(pB0,pB1,pA0,pA1,t,true,true,true);     WAIT_BAR(2); RESC(); ROT();
    STEP(pA0,pA1,pB0,pB1,t+1,true,true,true);   WAIT_BAR(2); RESC(); ROT();
  }
  #define ENDW(tt) do{ if((tt)+3<NT){WAIT_BAR(2);} else if((tt)+2<NT){WAIT_BAR(1);} else {WAIT_BAR(0);} }while(0)
  for(;t+1<NT;t+=2){
    STEP(pB0,pB1,pA0,pA1,t,(t+3<NT),(t+1<NT),(t+1<NT));       ENDW(t);   RESC(); ROT();
    STEP(pA0,pA1,pB0,pB1,t+1,(t+4<NT),(t+2<NT),(t+2<NT));     ENDW(t+1); RESC(); ROT();
  }
  STEP(pB0,pB1,pA0,pA1,NT-1,false,false,false); RESC();
  { float sacc=pB0[0]+pB0[1]; _Pragma("unroll") for(int r=2;r<16;++r)sacc+=pB0[r]; _Pragma("unroll") for(int r=0;r<16;++r)sacc+=pB1[r]; l_reg+=sacc;
    pw0=(u32x4){PKW(pB0,0),PKW(pB0,2),PKW(pB0,4),PKW(pB0,6)};pw1=(u32x4){PKW(pB0,8),PKW(pB0,10),PKW(pB0,12),PKW(pB0,14)};pw2=(u32x4){PKW(pB1,0),PKW(pB1,2),PKW(pB1,4),PKW(pB1,6)};pw3=(u32x4){PKW(pB1,8),PKW(pB1,10),PKW(pB1,12),PKW(pB1,14)};
    SBAR(); pv(o,vb0+sl_cur,PAF(0),PAF(1),PAF(2),PAF(3)); }
  #undef PKW
  #undef PAF
  #undef VFR
  #undef PIN
  #undef MX3
  #undef GAPA
  #undef GAPB
  #undef EX
  #undef VRD
  #undef KRD
  #undef STEP
  #undef ENDW
  {auto rr=__builtin_amdgcn_permlane32_swap(__float_as_uint(l_reg),__float_as_uint(l_reg),false,false);l_reg=__uint_as_float(rr[0])+__uint_as_float(rr[1]);}
  if(MODE==1) l_reg+=__builtin_amdgcn_exp2f(sinkl2-mhat);
  if(hi==0)wsf[32+r32]=l_reg;asm volatile("s_waitcnt lgkmcnt(0)":::"memory");
  float rli[16];
  #pragma unroll
  for(int r=0;r<16;++r)rli[r]=__builtin_amdgcn_rcpf(wsf[32+crow(r,hi)]);
  bf16*Ow=O+(rowbase+q0+wid*QBLK)*DM;
  { bf16*stg=(bf16*)(shm+LDS_OST)+wid*2048;
    #pragma unroll
    for(int r=0;r<16;++r){const int orow=crow(r,hi);
      #pragma unroll
      for(int d0=0;d0<2;++d0)stg[orow*64+d0*32+r32]=__float2bfloat16(o[d0][r]*rli[r]);}
    asm volatile("s_waitcnt lgkmcnt(0)":::"memory");
    #pragma unroll
    for(int i=0;i<4;++i){const int row=i*8+(lane>>3),ch=lane&7; const u32x4 v=*(const u32x4*)(stg+row*64+ch*8); ATTN_STORE16(Ow+(long)row*DM+ch*8,v);} }
  asm volatile("s_waitcnt lgkmcnt(0)\n\ts_barrier":::"memory");
  #undef DMA_K
  #undef DMA_V
  #undef CMASK
  #undef START
  #undef RESC
  #undef ROT
}
constexpr int ATTN_LDS_BYTES=LDS_BYTES;
#undef SBAR
#undef WAIT_BAR
}
#define LAS __attribute__((address_space(3)))
typedef unsigned short bf16_t;
typedef unsigned u32x4 __attribute__((ext_vector_type(4)));
typedef unsigned u32x2 __attribute__((ext_vector_type(2)));
typedef float f32x4 __attribute__((ext_vector_type(4)));
typedef short bf16x8 __attribute__((ext_vector_type(8)));

#ifndef MK_MULTI
#define MK_MULTI 0
#endif
#ifndef PROBE
#define PROBE 0
#endif
#ifndef PH_MASK
#define PH_MASK 0xFFFF
#endif
#define PHON(k) ((MASK >> (k)) & 1)
constexpr int NWAVES = 8, NTHR = 512, LDS_BYTES = 155648;
constexpr int NPH = 2 * 14 + 1;
constexpr size_t WS_HB = 0;
constexpr size_t WS_XB = WS_HB + (size_t)GT * PITCH * 2;
constexpr size_t WS_W1 = WS_XB + (size_t)GT * DMODEL * 2;
constexpr size_t WS_WB = WS_W1 + (size_t)5632 * 1024 * 2;
constexpr size_t WS_WO = WS_WB + (size_t)1024 * 1536 * 2;
constexpr size_t WS_WU = WS_WO + (size_t)1024 * 1024 * 2;
constexpr size_t WS_WD = WS_WU + (size_t)5632 * 1024 * 2;
constexpr size_t WS_HALO = WS_WD + (size_t)1024 * 2816 * 2;
constexpr size_t WS_SSQ1 = WS_HALO + (size_t)512 * PITCH * 2;
constexpr size_t WS_SSQ2 = WS_SSQ1 + (size_t)GT * 4;
constexpr size_t WS_BAR = WS_SSQ2 + (size_t)GT * 4;
constexpr size_t WS_END = WS_BAR + 16384;
static_assert(WS_END <= 268435456, "workspace map exceeds 256 MiB");

struct Params { const float* in[22]; float* out; unsigned char* ws; int lo, hi; };
enum { I_XP = 0, I_XS, I_RELB, I_N1G, I_WIN, I_LNG, I_LNB, I_WSP, I_BSP, I_SINK, I_QNG, I_KNG, I_WGATE, I_BGATE, I_WBR, I_WOUT, I_N2G, I_WUP, I_CW, I_CB, I_WDN, I_FING };

__device__ __forceinline__ const float* inp(const Params& P, int i) { asm volatile("" : "+s"(i)); return P.in[i]; }
__device__ __forceinline__ float wave_sum(float v) {
#pragma unroll
    for (int o = 1; o < 64; o <<= 1) v += __shfl_xor(v, o);
    return v;
}
__device__ __forceinline__ float bflo(unsigned w) { return __uint_as_float(w << 16); }
__device__ __forceinline__ float bfhi(unsigned w) { return __uint_as_float(w & 0xffff0000u); }
__device__ __forceinline__ unsigned short f2bf1(float f) { return (unsigned short)(pg8::cvt_pk_bf16(f, 0.f) & 0xffffu); }

struct WTile { const float* W; const float* gk; bf16_t* WT; int K, N, k0, n0, drow0; };
__device__ __forceinline__ WTile wprep_desc(const Params& P, unsigned char* ws, int l, int it) {
    WTile d; int r = it;
    const float* g1 = inp(P, I_N1G) + l * 1024; const float* g2 = inp(P, I_N2G) + l * 1024;
    if (r < 640) { const int kb = r / 40, nb = r % 40, sb = nb >> 1; const int db = sb < 4 ? sb : sb < 8 ? sb + 8 : sb < 12 ? sb - 4 : sb < 14 ? sb + 4 : sb < 18 ? sb - 6 : sb;
        d.W = inp(P, I_WIN) + (size_t)l * 1024 * 2560; d.K = 1024; d.N = 2560; d.k0 = kb * 64; d.n0 = nb * 64; d.gk = g1; d.WT = (bf16_t*)(ws + WS_W1); d.drow0 = db * 128 + (nb & 1) * 64; return d; } r -= 640;
    if (r < 768) { const int kb = r / 48, nb = r % 48; d.W = inp(P, I_WGATE) + (size_t)l * 1024 * 3072; d.K = 1024; d.N = 3072; d.k0 = kb * 64; d.n0 = nb * 64; d.gk = g1; d.WT = (bf16_t*)(ws + WS_W1); d.drow0 = 2560 + nb * 64; return d; } r -= 768;
    if (r < 384) { const int kb = r / 16, nb = r % 16; d.W = inp(P, I_WBR) + (size_t)l * 1536 * 1024; d.K = 1536; d.N = 1024; d.k0 = kb * 64; d.n0 = nb * 64; d.gk = nullptr; d.WT = (bf16_t*)(ws + WS_WB); d.drow0 = nb * 64; return d; } r -= 384;
    if (r < 256) { const int kb = r / 16, nb = r % 16; d.W = inp(P, I_WOUT) + (size_t)l * 1024 * 1024; d.K = 1024; d.N = 1024; d.k0 = kb * 64; d.n0 = nb * 64; d.gk = nullptr; d.WT = (bf16_t*)(ws + WS_WO); d.drow0 = nb * 64; return d; } r -= 256;
    if (r < 1408) { const int kb = r / 88, nb = r % 88; const int nv = nb >= 44 ? nb - 44 : nb;
        d.W = inp(P, I_WUP) + (size_t)l * 1024 * 5632; d.K = 1024; d.N = 5632; d.k0 = kb * 64; d.n0 = nb * 64; d.gk = g2; d.WT = (bf16_t*)(ws + WS_WU); d.drow0 = 256 * (nv >> 1) + (nb >= 44 ? 128 : 0) + 64 * (nv & 1); return d; } r -= 1408;
    { const int kb = r / 16, nb = r % 16; d.W = inp(P, I_WDN) + (size_t)l * 2816 * 1024; d.K = 2816; d.N = 1024; d.k0 = kb * 64; d.n0 = nb * 64; d.gk = nullptr; d.WT = (bf16_t*)(ws + WS_WD); d.drow0 = nb * 64; return d; }
}
__device__ __forceinline__ void wprep_load(const WTile& d, float (&v)[8], int tid) {
#pragma unroll
    for (int i = 0; i < 8; ++i) { const int kk = i * 8 + (tid >> 6), nn = tid & 63; float x = d.W[(size_t)(d.k0 + kk) * d.N + d.n0 + nn]; if (d.gk) x *= d.gk[d.k0 + kk]; v[i] = x; }
}
__device__ __forceinline__ void ph_wprep(const Params& P, int bid, int G, unsigned char* ws, int l, LAS unsigned char* lds, int tid) {
    asm volatile("" : "+v"(tid)); asm volatile("" : "+s"(bid)); asm volatile("" : "+s"(G));
    LAS float* scr = (LAS float*)lds;
    int it = bid; if (it >= 4160) return;
    WTile d = wprep_desc(P, ws, l, it); float v[8]; wprep_load(d, v, tid);
#pragma unroll 1
    for (;;) {
#pragma unroll
        for (int i = 0; i < 8; ++i) { const int kk = i * 8 + (tid >> 6), nn = tid & 63; scr[kk * 65 + nn] = v[i]; }
        __syncthreads();
        const WTile cur = d; const int nit = it + G; const bool more = nit < 4160;
        if (more) { d = wprep_desc(P, ws, l, nit); wprep_load(d, v, tid); }
        { const int n = tid >> 3, c = tid & 7; const LAS float* s = scr + (8 * c) * 65 + n;
          u32x4 o; o.x = pg8::cvt_pk_bf16(s[0], s[65]); o.y = pg8::cvt_pk_bf16(s[130], s[195]); o.z = pg8::cvt_pk_bf16(s[260], s[325]); o.w = pg8::cvt_pk_bf16(s[390], s[455]);
          *(u32x4*)(cur.WT + (size_t)(cur.drow0 + n) * cur.K + cur.k0 + 8 * c) = o; }
        __syncthreads();
        if (!more) break;
        it = nit;
    }
}

__device__ __forceinline__ void ph_p1(int bid, int G, unsigned char* ws, const float* xsrc, int tid) {
    asm volatile("" : "+v"(tid)); asm volatile("" : "+s"(bid)); asm volatile("" : "+s"(G));
    const int lane = tid & 63, wave = tid >> 6; bf16_t* XB = (bf16_t*)(ws + WS_XB); float* ssq1 = (float*)(ws + WS_SSQ1); float* ssq2 = (float*)(ws + WS_SSQ2);
    const int NGW = G * NWAVES;
    for (int row = bid * NWAVES + wave; row < GT; row += 2 * NGW) {
        const int row2 = row + NGW; const bool has2 = row2 < GT;
        const f32x4* xr = (const f32x4*)(xsrc + (size_t)row * DMODEL) + lane; const f32x4* xr2 = (const f32x4*)(xsrc + (size_t)(has2 ? row2 : row) * DMODEL) + lane;
        f32x4 v[4], v2[4]; float s = 0.f, s2 = 0.f;
#pragma unroll
        for (int j = 0; j < 4; ++j) { v[j] = xr[64 * j]; v2[j] = xr2[64 * j]; }
#pragma unroll
        for (int j = 0; j < 4; ++j) { s += (v[j].x * v[j].x + v[j].y * v[j].y) + (v[j].z * v[j].z + v[j].w * v[j].w); s2 += (v2[j].x * v2[j].x + v2[j].y * v2[j].y) + (v2[j].z * v2[j].z + v2[j].w * v2[j].w); }
        s = wave_sum(s); s2 = wave_sum(s2);
        u32x2* o = (u32x2*)(XB + (size_t)row * DMODEL) + lane;
#pragma unroll
        for (int j = 0; j < 4; ++j) { u32x2 w; w.x = pg8::cvt_pk_bf16(v[j].x, v[j].y); w.y = pg8::cvt_pk_bf16(v[j].z, v[j].w); o[64 * j] = w; }
        if (lane == 0) { ssq1[row] = s; ssq2[row] = 0.f; }
        if (has2) {
            u32x2* o2 = (u32x2*)(XB + (size_t)row2 * DMODEL) + lane;
#pragma unroll
            for (int j = 0; j < 4; ++j) { u32x2 w; w.x = pg8::cvt_pk_bf16(v2[j].x, v2[j].y); w.y = pg8::cvt_pk_bf16(v2[j].z, v2[j].w); o2[64 * j] = w; }
            if (lane == 0) { ssq1[row2] = s2; ssq2[row2] = 0.f; }
        }
    }
}

__device__ __forceinline__ void mixer_a_item(const Params& P, int l, int it, int par, bf16_t* HB, LAS unsigned char* lds, int tid) {
    const int ch = it >> 3, g8 = it & 7, r0 = ch * 128, lane = tid & 63, w = tid >> 6;
    LAS bf16_t* vT = (LAS bf16_t*)(lds + 16384 + par * 17408);
    const float* wsp = inp(P, I_WSP) + (((size_t)l * 8 + g8) * 128 + 16 * w + (lane & 15)) * 128 + 8 * (lane >> 4);
    f32x4 araw[8];
#pragma unroll
    for (int ks = 0; ks < 4; ++ks) { araw[2 * ks] = *(const f32x4*)(wsp + ks * 32); araw[2 * ks + 1] = *(const f32x4*)(wsp + ks * 32 + 4); }
    bf16_t* ub = HB + (size_t)(r0 + 16 * w + (lane & 15)) * PITCH + COL_U + g8 * 64 + 4 * (lane >> 4);
    u32x2 uraw[4];
#pragma unroll
    for (int nb = 0; nb < 4; ++nb) uraw[nb] = *(const u32x2*)(ub + 16 * nb);
    const float bs1 = inp(P, I_BSP)[((size_t)l * 8 + g8) * 128 + 16 * w + (lane & 15)];
    {
        const int q = tid >> 2, part = tid & 3;
        const bf16_t* vp = HB + (size_t)(r0 + q) * PITCH + COL_VA + part * 128;
        const int c0 = part * 16; const bf16_t* gp = HB + (size_t)(r0 + q) * PITCH + COL_VA + g8 * 64 + c0;
        const float* lg = inp(P, I_LNG) + l * 512 + g8 * 64 + c0; const float* lb = inp(P, I_LNB) + l * 512 + g8 * 64 + c0;
        u32x4 sv[16], gvw[2]; f32x4 lgv[4], lbv[4];
#pragma unroll
        for (int i = 0; i < 16; ++i) sv[i] = *(const u32x4*)(vp + 8 * i);
#pragma unroll
        for (int hh = 0; hh < 2; ++hh) gvw[hh] = *(const u32x4*)(gp + 8 * hh);
#pragma unroll
        for (int i = 0; i < 4; ++i) { lgv[i] = *(const f32x4*)(lg + 4 * i); lbv[i] = *(const f32x4*)(lb + 4 * i); }
        __builtin_amdgcn_sched_barrier(0);
        float s = 0.f, s2 = 0.f;
#pragma unroll
        for (int i = 0; i < 16; ++i) {
#pragma unroll
            for (int e = 0; e < 4; ++e) { const float a = bflo(sv[i][e]), b = bfhi(sv[i][e]); s += a + b; s2 += a * a + b * b; } }
        s += __shfl_xor(s, 1); s += __shfl_xor(s, 2); s2 += __shfl_xor(s2, 1); s2 += __shfl_xor(s2, 2);
        const float mean = s * (1.0f / 512.0f), var = fmaxf(s2 * (1.0f / 512.0f) - mean * mean, 0.f), rstd = rsqrtf(var + EPSN);
#pragma unroll
        for (int hh = 0; hh < 2; ++hh) { const u32x4 wv = gvw[hh];
#pragma unroll
            for (int e = 0; e < 4; ++e) { const int i = hh * 8 + e * 2;
                const float ga = lgv[i >> 2][i & 3], gb = lgv[(i + 1) >> 2][(i + 1) & 3], ba = lbv[i >> 2][i & 3], bb = lbv[(i + 1) >> 2][(i + 1) & 3];
                const float y0 = (bflo(wv[e]) - mean) * rstd * ga + ba, y1 = (bfhi(wv[e]) - mean) * rstd * gb + bb;
                vT[(c0 + i) * 136 + q] = f2bf1(y0); vT[(c0 + i + 1) * 136 + q] = f2bf1(y1); } }
    }
    __builtin_amdgcn_sched_barrier(0);
    bf16x8 afr[4];
#pragma unroll
    for (int ks = 0; ks < 4; ++ks) { const u32x4 aw = pg8::pack8(araw[2 * ks], araw[2 * ks + 1]); afr[ks] = __builtin_bit_cast(bf16x8, aw); }
    __syncthreads();
    f32x4 acc[4];
#pragma unroll
    for (int nb = 0; nb < 4; ++nb) acc[nb] = (f32x4){0.f, 0.f, 0.f, 0.f};
#pragma unroll
    for (int ks = 0; ks < 4; ++ks) {
#pragma unroll
        for (int nb = 0; nb < 4; ++nb) { const bf16x8 b = *(const LAS bf16x8*)(vT + (16 * nb + (lane & 15)) * 136 + ks * 32 + 8 * (lane >> 4));
            acc[nb] = __builtin_amdgcn_mfma_f32_16x16x32_bf16(b, afr[ks], acc[nb], 0, 0, 0); }
        __builtin_amdgcn_sched_barrier(0);
    }
#pragma unroll
    for (int nb = 0; nb < 4; ++nb) {
        u32x2 o; o.x = pg8::cvt_pk_bf16(bflo(uraw[nb].x) * (acc[nb][0] + bs1), bfhi(uraw[nb].x) * (acc[nb][1] + bs1)); o.y = pg8::cvt_pk_bf16(bflo(uraw[nb].y) * (acc[nb][2] + bs1), bfhi(uraw[nb].y) * (acc[nb][3] + bs1));
        *(u32x2*)(ub + 16 * nb) = o;
        __builtin_amdgcn_sched_barrier(0); }
}
__device__ __forceinline__ void ph_p3a(const Params& P, int bid, int G, unsigned char* ws, int l, int g, LAS unsigned char* lds, int tid, const int mode = 0) {
    asm volatile("" : "+v"(tid)); asm volatile("" : "+s"(bid)); asm volatile("" : "+s"(G));
    bf16_t* HB = (bf16_t*)(ws + WS_HB);
    LAS float* tab = (LAS float*)lds;
    for (int e = tid; e < 1024; e += NTHR) { const int pos = e >> 4, i = e & 15; const float inv = __builtin_amdgcn_exp2f(-(float)i * (13.287712379549449f / 16.0f)), rev = (float)pos * inv * 0.15915494309189535f; tab[2 * e] = __builtin_amdgcn_cosf(rev); tab[2 * e + 1] = __builtin_amdgcn_sinf(rev); }
    __syncthreads();
    if (mode != 2) { int par = 0;
#pragma unroll 1
      for (int i = 0, it0 = bid; it0 < 1024; ++i, it0 += G) {
          int it = it0; if (G == 256) { const int x = bid & 7, j = (bid >> 3) + 32 * i; it = ((x * 16 + (j >> 3)) << 3) + (j & 7); }
          mixer_a_item(P, l, it, par, HB, lds, tid); par ^= 1; } }
    __syncthreads();
    const int S = g == 0 ? 2048 : 4096;
    if (mode != 1)
    for (int idx = bid * NTHR + tid; idx < GT * 20; idx += G * NTHR) {
        const int half = idx & 1, th = idx >> 1, t = th / 10, hh = th - t * 10; const bool isq = hh < 8;
        bf16_t* p = HB + (size_t)t * PITCH + (isq ? COL_QC + hh * 64 : COL_KC + (hh - 8) * 64) + half * 32;
        const float* gain = (isq ? inp(P, I_QNG) : inp(P, I_KNG)) + l * 64 + half * 32; const float sc = isq ? QK_C2 : 1.0f;
        float x[32]; float ssq = 0.f;
        u32x4 xw[4]; f32x4 gvv[8];
#pragma unroll
        for (int i = 0; i < 4; ++i) xw[i] = *(const u32x4*)(p + 8 * i);
#pragma unroll
        for (int i = 0; i < 8; ++i) gvv[i] = *(const f32x4*)(gain + 4 * i);
        __builtin_amdgcn_sched_barrier(0);
#pragma unroll
        for (int i = 0; i < 4; ++i) {
#pragma unroll
            for (int e = 0; e < 4; ++e) { x[8 * i + 2 * e] = bflo(xw[i][e]); x[8 * i + 2 * e + 1] = bfhi(xw[i][e]); } }
#pragma unroll
        for (int i = 0; i < 32; ++i) ssq += x[i] * x[i];
        ssq += __shfl_xor(ssq, 1);
        const float rstd = rsqrtf(ssq * (1.0f / 64.0f) + EPSN);
#pragma unroll
        for (int i = 0; i < 8; ++i) {
#pragma unroll
            for (int e = 0; e < 4; ++e) x[4 * i + e] = x[4 * i + e] * rstd * gvv[i][e]; }
        const int ts = t & (S - 1), pos = half ? (ts & 63) : (ts >> 6);
#pragma unroll
        for (int i = 0; i < 16; ++i) { const float cs = tab[(pos * 16 + i) * 2], sn = tab[(pos * 16 + i) * 2 + 1]; const float x1 = x[i], x2 = x[16 + i];
            x[i] = (x1 * cs - x2 * sn) * sc; x[16 + i] = (x2 * cs + x1 * sn) * sc; }
#pragma unroll
        for (int i = 0; i < 4; ++i) { u32x4 wv;
#pragma unroll
            for (int e = 0; e < 4; ++e) wv[e] = pg8::cvt_pk_bf16(x[8 * i + 2 * e], x[8 * i + 2 * e + 1]);
            *(u32x4*)(p + 8 * i) = wv; }
    }
}

__device__ __forceinline__ int t5_bucket(int rel) {
    const int n = rel < 0 ? -rel : rel; int b;
    if (n < 8) b = n; else { b = 8 + (n >= 12) + (n >= 16) + (n >= 23) + (n >= 32) + (n >= 46) + (n >= 64) + (n >= 91); }
    return b + (rel > 0 ? 16 : 0);
}
constexpr int BT_OFF = 86016, BT_PITCH = 260;
__device__ __forceinline__ void ph_p3b(const Params& P, int bid, int G, unsigned char* ws, int l, int g, unsigned char* lds_gen, LAS unsigned char* lds, int tid, const int which = 0) {
    asm volatile("" : "+v"(tid)); asm volatile("" : "+s"(bid)); asm volatile("" : "+s"(G));
    using abf = attn_body::bf16;
    LAS float* bt = (LAS float*)(lds + BT_OFF);
    for (int e = tid; e < 8 * 257; e += NTHR) { const int h = e / 257, i = e - h * 257; bt[h * BT_PITCH + i] = inp(P, I_RELB)[t5_bucket(i - 128) * 8 + h] * 1.4426950408889634f; }
    __syncthreads();
    const abf* HB = (const abf*)(ws + WS_HB); abf* HBw = (abf*)(ws + WS_HB);
    const int S = g == 0 ? 2048 : 4096;
    if (which != 2)
    for (int u = bid; u < 512; u += G) {
        const int h = u & 7, r = (u >> 3) * 256, q0 = r & (S - 1); const long rowbase = r - q0;
        attn_body::attn_unit<8, 0>(rowbase, q0, 0, S / 64, HB + COL_QC + h * 64, HB + COL_KC + (h >> 2) * 64, HB + COL_VC + (h >> 2) * 64, HBw + COL_QC + h * 64, (char*)lds_gen, (attn_body::lds_fptr)bt, 0.f, tid);
    }
    if (which != 1)
    for (int u = bid; u < 512; u += G) {
        const int h = u & 7, r = (u >> 3) * 256, q0 = r & (S - 1); const long rowbase = r - q0;
        const int kt0 = q0 >= 128 ? q0 - 128 : 0, kend = (q0 + 384 <= S) ? q0 + 384 : S;
        attn_body::attn_unit<8, 1>(rowbase, q0, kt0, (kend - kt0) / 64, HB + COL_QB + h * 64, HB + COL_KB + (h >> 2) * 64, HB + COL_VB + (h >> 2) * 64, HBw + COL_QB + h * 64, (char*)lds_gen,
                                   (attn_body::lds_fptr)(bt + h * BT_PITCH), inp(P, I_SINK)[l * 8 + h] * 1.4426950408889634f, tid);
    }
}

__device__ __forceinline__ void unpack8(const u32x4 w, float (&o)[8]) {
#pragma unroll
    for (int e = 0; e < 4; ++e) { o[2 * e] = bflo(w[e]); o[2 * e + 1] = bfhi(w[e]); }
}
__device__ __forceinline__ void ph_conv(const Params& P, int bid, int G, unsigned char* ws, int l, int g, int tid) {
    asm volatile("" : "+v"(tid)); asm volatile("" : "+s"(bid)); asm volatile("" : "+s"(G));
    bf16_t* HB = (bf16_t*)(ws + WS_HB); const bf16_t* halo = (const bf16_t*)(ws + WS_HALO);
    const int S = g == 0 ? 2048 : 4096;
    const float* cw = inp(P, I_CW) + (size_t)l * 3 * 5632; const float* cb = inp(P, I_CB) + (size_t)l * 5632;
    for (int gt = bid * NTHR + tid; gt < 256 * 352; gt += G * NTHR) {
        const int rb = gt / 352, ci = gt - rb * 352, r0 = rb * 64, cg0 = ci * 8, cv0 = DFF + ci * 8;
        float wg[3][8], wv[3][8], bg[8], bv[8];
#pragma unroll
        for (int k = 0; k < 3; ++k)
#pragma unroll
            for (int e = 0; e < 8; ++e) { wg[k][e] = cw[k * 5632 + cg0 + e]; wv[k][e] = cw[k * 5632 + cv0 + e]; }
#pragma unroll
        for (int e = 0; e < 8; ++e) { bg[e] = cb[cg0 + e]; bv[e] = cb[cv0 + e]; }
        const bool topz = (r0 & (S - 1)) == 0, botz = ((r0 + 64) & (S - 1)) == 0;
        float pgt[8], pvl[8], cgt[8], cvl[8];
        if (topz) {
#pragma unroll
            for (int e = 0; e < 8; ++e) { pgt[e] = 0.f; pvl[e] = 0.f; }
        } else { const bf16_t* hp = halo + (size_t)((rb - 1) * 2 + 1) * PITCH; unpack8(*(const u32x4*)(hp + cg0), pgt); unpack8(*(const u32x4*)(hp + cv0), pvl); }
        { const bf16_t* rp = HB + (size_t)r0 * PITCH; unpack8(*(const u32x4*)(rp + cg0), cgt); unpack8(*(const u32x4*)(rp + cv0), cvl); }
#pragma unroll 1
        for (int rr = 0; rr < 64; rr += 8) {
            u32x4 ng[8], nv[8];
#pragma unroll
            for (int j = 0; j < 8; ++j) {
                if (rr + j + 1 < 64) { const bf16_t* rp = HB + (size_t)(r0 + rr + j + 1) * PITCH; ng[j] = *(const u32x4*)(rp + cg0); nv[j] = *(const u32x4*)(rp + cv0); }
                else if (botz) { ng[j] = (u32x4){0u, 0u, 0u, 0u}; nv[j] = (u32x4){0u, 0u, 0u, 0u}; }
                else { const bf16_t* hp = halo + (size_t)((rb + 1) * 2) * PITCH; ng[j] = *(const u32x4*)(hp + cg0); nv[j] = *(const u32x4*)(hp + cv0); }
            }
#pragma unroll
            for (int j = 0; j < 8; ++j) {
                float ngt[8], nvl[8]; unpack8(ng[j], ngt); unpack8(nv[j], nvl);
                float o[8];
#pragma unroll
                for (int e = 0; e < 8; ++e) { const float a = pgt[e] * wg[0][e] + cgt[e] * wg[1][e] + ngt[e] * wg[2][e] + bg[e]; const float b = pvl[e] * wv[0][e] + cvl[e] * wv[1][e] + nvl[e] * wv[2][e] + bv[e];
                    o[e] = pg8::silu_f(a) * b; pgt[e] = cgt[e]; pvl[e] = cvl[e]; cgt[e] = ngt[e]; cvl[e] = nvl[e]; }
                u32x4 w; w.x = pg8::cvt_pk_bf16(o[0], o[1]); w.y = pg8::cvt_pk_bf16(o[2], o[3]); w.z = pg8::cvt_pk_bf16(o[4], o[5]); w.w = pg8::cvt_pk_bf16(o[6], o[7]);
                *(u32x4*)(HB + (size_t)(r0 + rr + j) * PITCH + cg0) = w;
            }
        }
    }
}

__device__ __forceinline__ void ph_final(const Params& P, int bid, int G, int tid) {
    asm volatile("" : "+v"(tid)); asm volatile("" : "+s"(bid)); asm volatile("" : "+s"(G));
    const int lane = tid & 63, wave = tid >> 6; const f32x4* gp = (const f32x4*)inp(P, I_FING) + lane;
    const int NGW = G * NWAVES;
    f32x4 gv[4];
#pragma unroll
    for (int j = 0; j < 4; ++j) gv[j] = gp[64 * j];
    for (int row = bid * NWAVES + wave; row < 2 * GT; row += 2 * NGW) {
        const int row2 = row + NGW; const bool has2 = row2 < 2 * GT;
        f32x4* xr = (f32x4*)(P.out + (size_t)row * DMODEL) + lane; f32x4* xr2 = (f32x4*)(P.out + (size_t)(has2 ? row2 : row) * DMODEL) + lane;
        f32x4 v[4], v2[4]; float s = 0.f, s2 = 0.f;
#pragma unroll
        for (int j = 0; j < 4; ++j) { v[j] = xr[64 * j]; v2[j] = xr2[64 * j]; }
#pragma unroll
        for (int j = 0; j < 4; ++j) { s += (v[j].x * v[j].x + v[j].y * v[j].y) + (v[j].z * v[j].z + v[j].w * v[j].w); s2 += (v2[j].x * v2[j].x + v2[j].y * v2[j].y) + (v2[j].z * v2[j].z + v2[j].w * v2[j].w); }
        const float rs = rsqrtf(wave_sum(s) * (1.0f / 1024.0f) + EPSN), rs2 = rsqrtf(wave_sum(s2) * (1.0f / 1024.0f) + EPSN);
#pragma unroll
        for (int j = 0; j < 4; ++j) xr[64 * j] = v[j] * rs * gv[j];
        if (has2) {
#pragma unroll
            for (int j = 0; j < 4; ++j) xr2[64 * j] = v2[j] * rs2 * gv[j];
        }
    }
}

#define XB_TMO      128
#define XB_XCNT(j)  (256  + 64 * (j))
#define XB_XSUB(j)  (1280 + 64 * (j))
#define XB_XGEN(j)  (2304 + 64 * (j))
#define XB_TOP      3328
#define XB_TOPGEN   3392
#define XCD_BAR_WORDS 3456
#define XB_SPIN_CAP (1u << 22)
__device__ __forceinline__ unsigned xb_ld(unsigned* p)              { return __hip_atomic_load(p, __ATOMIC_RELAXED, __HIP_MEMORY_SCOPE_AGENT); }
__device__ __forceinline__ unsigned xb_add(unsigned* p, unsigned v) { return __hip_atomic_fetch_add(p, v, __ATOMIC_RELAXED, __HIP_MEMORY_SCOPE_AGENT); }
__device__ __forceinline__ unsigned xb_xcc_id() { return (unsigned)__builtin_amdgcn_s_getreg((3 << 11) | 20) & 0xFu; }
#define XB_SPIN(cond, bar) do { unsigned _sp = 0; while (cond) { __builtin_amdgcn_s_sleep(1); \
    if ((++_sp & 255u) == 0u) { if (xb_ld(&(bar)[XB_TMO])) break; if (_sp > XB_SPIN_CAP) { atomicAdd(&(bar)[XB_TMO], 1u); break; } } } } while (0)
__device__ __forceinline__ void xcd_barrier_complete(unsigned* bar, unsigned x, unsigned G, unsigned& nloc, unsigned& nx) {
    unsigned sum, cnt, mine, sp = 0u;
    for (;;) {
        sum = 0u; cnt = 0u; mine = 0u;
#pragma unroll
        for (unsigned j = 0; j < 16; ++j) { const unsigned c = xb_ld(&bar[XB_XCNT(j)]); sum += c; cnt += (c > 0u) ? 1u : 0u; mine = (j == x) ? c : mine; }
        if (sum == G) break;
        __builtin_amdgcn_s_sleep(1);
        if ((++sp & 255u) == 0u) { if (xb_ld(&bar[XB_TMO])) break; if (sp > XB_SPIN_CAP) { atomicAdd(&bar[XB_TMO], 1u); break; } }
    }
    nloc = mine > 0u ? mine : 1u; nx = cnt > 0u ? cnt : 1u;
}
__device__ __forceinline__ void grid_bar(unsigned* bar, volatile LAS unsigned* st, unsigned G, int tid) {
    asm volatile("s_waitcnt vmcnt(0) lgkmcnt(0)" ::: "memory");
    __syncthreads();
    if (tid == 0) {
        const unsigned x = xb_xcc_id();
        __builtin_amdgcn_s_waitcnt(0);
        unsigned nloc = st[0], nx = st[1];
        if (nloc == 0u) { xcd_barrier_complete(bar, x, G, nloc, nx); st[0] = nloc; st[1] = nx; }
        const unsigned old = xb_add(&bar[XB_XSUB(x)], 1u);
        const unsigned gen = old / nloc;
        if (old + 1u == (gen + 1u) * nloc) {
            __builtin_amdgcn_fence(__ATOMIC_RELEASE, "agent");
            asm volatile("s_waitcnt vmcnt(0)" ::: "memory");
            const unsigned og = xb_add(&bar[XB_TOP], 1u);
            const unsigned tg = og / nx;
            if (og + 1u == (tg + 1u) * nx) xb_add(&bar[XB_TOPGEN], 1u);
            else XB_SPIN(xb_ld(&bar[XB_TOPGEN]) == tg, bar);
            __builtin_amdgcn_fence(__ATOMIC_ACQUIRE, "agent");
            xb_add(&bar[XB_XGEN(x)], 1u);
            asm volatile("s_waitcnt vmcnt(0)" ::: "memory");
        } else {
            XB_SPIN(xb_ld(&bar[XB_XGEN(x)]) == gen, bar);
            __builtin_amdgcn_fence(__ATOMIC_ACQUIRE, "agent");
            asm volatile("s_waitcnt vmcnt(0)" ::: "memory");
        }
    }
    __syncthreads();
}
constexpr int BARST_OFF = LDS_BYTES - 64;
#define PH_BEGIN(I) { int lo = P.lo, hi = P.hi; asm volatile("" : "+v"(lo)); asm volatile("" : "+v"(hi));   if ((I) >= lo && (I) < hi) { \
        int tid = wave_s * 64 + (int)__builtin_amdgcn_mbcnt_hi(~0u, __builtin_amdgcn_mbcnt_lo(~0u, 0u)); asm volatile("" : "+v"(tid)); \
        unsigned char* ws = P.ws; asm volatile("" : "+s"(ws)); int G = gridDim.x; asm volatile("" : "+s"(G)); int bid = blockIdx.x; asm volatile("" : "+s"(bid)); \
        if ((I) > lo) grid_bar((unsigned*)(ws + WS_BAR), (volatile LAS unsigned*)(lds + BARST_OFF), (unsigned)G, tid); \
        bf16_t* HB = (bf16_t*)(ws + WS_HB); bf16_t* XB = (bf16_t*)(ws + WS_XB); float* ssq1 = (float*)(ws + WS_SSQ1); float* ssq2 = (float*)(ws + WS_SSQ2); (void)HB; (void)XB; (void)ssq1; (void)ssq2; (void)tid; (void)G; (void)bid;
#define PH_END } }
#define BAR2(k) grid_bar((unsigned*)(ws + WS_BAR), (volatile LAS unsigned*)(lds + BARST_OFF), (unsigned)G, tid)
template <int MASK, int L, int GR> __device__ __forceinline__ void run_lg(const Params& P, const int wave_s, unsigned char* lds_raw, LAS unsigned char* lds) {
    constexpr int I0 = L * 14 + GR * 7;
    PH_BEGIN(I0 + 0) { const float* xsrc = L == 0 ? inp(P, GR) : (const float*)(P.out + (size_t)GR * GT * DMODEL);
        if (GR == 0 && PHON(9)) ph_wprep(P, bid, G, ws, L, lds, tid);
        if (PHON(0)) ph_p1(bid, G, ws, xsrc, tid); } PH_END
    PH_BEGIN(I0 + 1) if (PHON(1)) {
        pg8::Gemm gm{XB, (const bf16_t*)(ws + WS_W1), 1024, 1024, 1024}; pg8::Order S; S.init(GT, 5632, G, bid, 1, 0);
        { LAS float* rt = (LAS float*)(lds + 139264);
          for (int e = tid; e < 1024; e += NTHR) { const int pos = e >> 4, i = e & 15; const float inv = __builtin_amdgcn_exp2f(-(float)i * (13.287712379549449f / 16.0f)), rev = (float)pos * inv * 0.15915494309189535f; rt[2 * e] = __builtin_amdgcn_cosf(rev); rt[2 * e + 1] = __builtin_amdgcn_sinf(rev); }
          __syncthreads(); }
        pg8::Epi1 E{HB, ssq1, inp(P, I_BGATE) + L * 3072, inp(P, I_QNG) + L * 64, inp(P, I_KNG) + L * 64, (PG8_LAS float*)(lds + 131072), (const PG8_LAS float*)(lds + 139264), (GR == 0 ? 2048 : 4096) - 1};
        pg8::gemm_phase<pg8::Epi1, pg8::Order, true, true>(lds, gm, S, E, tid);
        if (PROBE == 2) { __syncthreads(); pg8::gemm_phase<pg8::Epi1, pg8::Order, true, true>(lds, gm, S, E, tid); } } PH_END
    PH_BEGIN(I0 + 2) if (PHON(3)) {
        ph_p3a(P, bid, G, ws, L, GR, lds, tid, 1); __syncthreads();
        ph_p3b(P, bid, G, ws, L, GR, lds_raw, lds, tid); } PH_END
    PH_BEGIN(I0 + 3) if (PHON(4)) {
        pg8::Gemm gm{HB, (const bf16_t*)(ws + WS_WB), PITCH, 1536, 512}; pg8::Order S; S.init(GT, 1024, G, bid, 3, 512);
        pg8::Epi4 E{HB};
        pg8::gemm_phase<pg8::Epi4, pg8::Order, true, true>(lds, gm, S, E, tid);
        if (PROBE == 4) { __syncthreads(); pg8::gemm_phase<pg8::Epi4, pg8::Order, true, true>(lds, gm, S, E, tid); } } PH_END
    PH_BEGIN(I0 + 4) if (PHON(5)) {
        float* xdst = P.out + (size_t)GR * GT * DMODEL; const float* xsrc = L == 0 ? inp(P, GR) : (const float*)xdst;
        pg8::Gemm gm{HB + COL_MERGED, (const bf16_t*)(ws + WS_WO), PITCH, 1024, 1024}; pg8::Order S; S.init(GT, 1024, G, bid, 1, 0);
        pg8::Epi5 E{xsrc, xdst, XB, ssq2};
        pg8::gemm_phase<pg8::Epi5, pg8::Order, true, true>(lds, gm, S, E, tid); } PH_END
    PH_BEGIN(I0 + 5) if (PHON(6)) {
        pg8::Gemm gm{XB, (const bf16_t*)(ws + WS_WU), 1024, 1024, 1024}; pg8::Order S; S.init_ovl(65, 5632, G, bid);
        pg8::Epi7f E{HB, ssq2, inp(P, I_CW) + (size_t)L * 3 * 5632, inp(P, I_CB) + (size_t)L * 5632, (PG8_LAS float*)(lds + 131072), (GR == 0 ? 2048 : 4096) - 1, GT};
        pg8::gemm_phase<pg8::Epi7f, pg8::Order, true, true>(lds, gm, S, E, tid); } PH_END
    PH_BEGIN(I0 + 6) if (PHON(5)) {
        float* xdst = P.out + (size_t)GR * GT * DMODEL;
        pg8::Gemm gm{HB, (const bf16_t*)(ws + WS_WD), PITCH, 2816, 2816}; pg8::Order S; S.init(GT, 1024, G, bid, 1, 0);
        pg8::Epi5 E{xdst, xdst, nullptr, nullptr};
        pg8::gemm_phase<pg8::Epi5, pg8::Order, true, true>(lds, gm, S, E, tid); } PH_END
}
template <int MASK> __device__ __forceinline__ void fwd_body(const Params& P) {
    extern __shared__ __attribute__((aligned(16))) unsigned char lds_raw[];
    LAS unsigned char* lds = (LAS unsigned char*)lds_raw;
    const int wave_s = __builtin_amdgcn_readfirstlane((int)threadIdx.x >> 6);
    { if (threadIdx.x == 0) { ((volatile LAS unsigned*)(lds + BARST_OFF))[0] = 0u; ((volatile LAS unsigned*)(lds + BARST_OFF))[1] = 0u; (void)xb_add((unsigned*)(P.ws + WS_BAR) + XB_XCNT(xb_xcc_id()), 1u); } __syncthreads(); }
    if (P.hi < 0) { cg::grid_group grid = cg::this_grid(); grid.sync(); }
    run_lg<MASK, 0, 0>(P, wave_s, lds_raw, lds);
    run_lg<MASK, 0, 1>(P, wave_s, lds_raw, lds);
    run_lg<MASK, 1, 0>(P, wave_s, lds_raw, lds);
    run_lg<MASK, 1, 1>(P, wave_s, lds_raw, lds);
    PH_BEGIN(NPH - 1) if (PHON(10)) ph_final(P, bid, G, tid); PH_END
}

#if MK_MULTI
#define DEFK(name, mask) __global__ void __launch_bounds__(NTHR, 2) name(Params P) { fwd_body<mask>(P); }
DEFK(fwd_k0, 0x001) DEFK(fwd_k1, 0x002) DEFK(fwd_k2, 0x004) DEFK(fwd_k3, 0x008) DEFK(fwd_k4, 0x010) DEFK(fwd_k5, 0x020) DEFK(fwd_k6, 0x040) DEFK(fwd_k7, 0x080) DEFK(fwd_k9, 0x200) DEFK(fwd_k10, 0x400)
#define fwd_kernel fwd_k3
#else
__global__ void __launch_bounds__(NTHR, 2) fwd_kernel(Params P) { fwd_body<PH_MASK>(P); }
#endif

extern "C" void kernel_launch(void* const* d_in, const int* in_sizes, int n_in, void* d_out, int out_size, void* d_ws, size_t ws_size, hipStream_t stream) {
    static int grid = 0;
    if (grid == 0) {
        if (n_in != 22 || out_size != 2 * GT * DMODEL || ws_size < WS_END) { fprintf(stderr, "kernel_launch: unexpected shapes (n_in %d out %d ws %zu)\n", n_in, out_size, ws_size); grid = -1; return; }
        int dev = 0, cus = 0, per_cu = 0;
        if (hipGetDevice(&dev) != hipSuccess || hipDeviceGetAttribute(&cus, hipDeviceAttributeMultiprocessorCount, dev) != hipSuccess) { grid = -1; return; }
        if (hipFuncSetAttribute((const void*)fwd_kernel, hipFuncAttributeMaxDynamicSharedMemorySize, LDS_BYTES) != hipSuccess) { fprintf(stderr, "kernel_launch: hipFuncSetAttribute failed\n"); grid = -1; return; }
        if (hipOccupancyMaxActiveBlocksPerMultiprocessor(&per_cu, (const void*)fwd_kernel, NTHR, LDS_BYTES) != hipSuccess || per_cu < 1) { fprintf(stderr, "kernel_launch: occupancy query says %d\n", per_cu); per_cu = 1; }
        (void)hipGetLastError();
        grid = cus;
    }
    if (grid < 0) return;
    (void)hipMemsetAsync((unsigned char*)d_ws + WS_BAR, 0, 16384, stream);
    Params p{};
    for (int i = 0; i < 22; ++i) p.in[i] = (const float*)d_in[i];
    p.out = (float*)d_out; p.ws = (unsigned char*)d_ws;
#if MK_MULTI
    typedef void (*kfn)(Params);
    const kfn kf[11] = {fwd_k0, fwd_k1, fwd_k2, fwd_k3, fwd_k4, fwd_k5, fwd_k6, fwd_k5, fwd_k5, fwd_k9, fwd_k10};
    for (int i = 0; i < 11; ++i) (void)hipFuncSetAttribute((const void*)kf[i], hipFuncAttributeMaxDynamicSharedMemorySize, LDS_BYTES);
    for (int i = 0; i < NPH; ++i) { p.lo = i; p.hi = i + 1;
        const int r = i % 17; const int k = (i == NPH - 1) ? 10 : (r == 0 ? 9 : (r - 1) % 8);
        hipLaunchKernelGGL(kf[k], dim3(grid), dim3(NTHR), LDS_BYTES, stream, p);
        if (PROBE == 8 && k == 3) { for (int d = 2; d >= 0; --d) { p.lo = i - d; p.hi = i - d + 1; hipLaunchKernelGGL(kf[k - d], dim3(grid), dim3(NTHR), LDS_BYTES, stream, p); } } }
#else
    p.lo = 0; p.hi = NPH;
    void* args[] = {&p};
    hipError_t e = hipLaunchCooperativeKernel((const void*)fwd_kernel, dim3(grid), dim3(NTHR), args, LDS_BYTES, stream);
    if (e != hipSuccess) fprintf(stderr, "cooperative launch failed: %s (grid %d)\n", hipGetErrorString(e), grid);
#endif
}
```

```cpp
#include <hip/hip_runtime.h>
#include <hip/hip_cooperative_groups.h>
#include <hip/hip_bf16.h>
#include <cstdio>
#include <cstdint>
#include <cmath>
namespace cg = cooperative_groups;

constexpr int DMODEL = 1024, GT = 16384  , PITCH = 5632  , DFF = 2816;
constexpr int COL_U = 0, COL_QB = 512, COL_QC = 1024, COL_VA = 1536, COL_KB = 2048, COL_VB = 2176, COL_KC = 2304, COL_VC = 2432, COL_MERGED = 1536, COL_GATE = 2560;
constexpr float EPSN = 1e-6f;
constexpr float QK_C2 = 0.125f * 1.4426950408889634f;
__device__ __forceinline__ int otid() { int t = threadIdx.x; asm volatile("" : "+v"(t)); return t; }
__device__ __forceinline__ int obid() { int t = blockIdx.x; asm volatile("" : "+s"(t)); return t; }
__device__ __forceinline__ int ogdim() { int t = gridDim.x; asm volatile("" : "+s"(t)); return t; }

namespace pg8 {
#define PG8_LAS __attribute__((address_space(3)))
typedef unsigned short bf16_t;
typedef short bf16x8 __attribute__((ext_vector_type(8)));
typedef float f32x4 __attribute__((ext_vector_type(4)));
typedef unsigned u32x4 __attribute__((ext_vector_type(4)));
constexpr int BM = 256, BK = 64, HALF = 128, HTB = HALF * BK * 2  , STAGE_BYTES = 8 * HTB, NXCD = 8, WGM = 8;

__host__ __device__ __forceinline__ int lds_byte(int r, int c) { const int st = (r >> 4) * 2 + (c >> 5), rr = r & 15, cc = c & 31, ob = rr * 64 + cc * 2; return st * 1024 + (ob ^ (((ob >> 9) & 1) << 5)); }
__host__ __device__ __forceinline__ void stage_rc(int b, int& R, int& C) { const int st = b / 1024, sb = b % 1024, swz = sb ^ (((sb >> 9) & 1) << 5); R = (st >> 1) * 16 + swz / 64; C = (st & 1) * 32 + (swz % 64) / 2; }
__host__ __device__ __forceinline__ int perm32(int rho) { const int n = rho >> 4, i = rho & 15; return 8 * (i >> 2) + 4 * n + (i & 3); }

struct Unit { int pm, pn, ko, n, arow; };
struct Gemm { const bf16_t* A; const bf16_t* Bt; int lda, ldb, K; };


struct Order {
    int nM, nN, nwg, G, c, rep, kstep, ovl;
    __device__ void init(int M, int N, int G_, int c_, int rep_, int kstep_) { nM = M / BM; nN = N / BM; nwg = nM * nN; G = G_; c = c_; rep = rep_; kstep = kstep_; ovl = 0; }
    __device__ void init_ovl(int nM_, int N, int G_, int c_) { nM = nM_; nN = N / BM; nwg = nM * nN; G = G_; c = c_; rep = 1; kstep = 0; ovl = 1; }
    __device__ bool next(int i, Unit& u) const {
        int ti = i, n = 0; if (rep == 3) { ti = i / 3; n = i - ti * 3; }
        const long L = (long)ti * G + c; if (L >= nwg) return false;
        int wgid = (int)L; { const int q = nwg / NXCD, r = nwg % NXCD, xcd = wgid % NXCD, off = wgid / NXCD; wgid = (xcd < r ? xcd * (q + 1) : r * (q + 1) + (xcd - r) * q) + off; }
        const int nig = WGM * nN, gid = wgid / nig, fm = gid * WGM, gsz = (nM - fm) < WGM ? (nM - fm) : WGM;
        u.pm = fm + ((wgid % nig) % gsz); u.pn = (wgid % nig) / gsz; u.ko = n * kstep; u.n = n; u.arow = ovl ? (u.pm ? 254 * u.pm - 1 : 0) : u.pm * BM; return true;
    }
    __device__ __forceinline__ void a_ready(const Unit&) const {}
    __device__ __forceinline__ void done(const Unit&) const {}
};

__device__ __forceinline__ unsigned cvt_pk_bf16(float lo, float hi) { unsigned r; asm volatile("v_cvt_pk_bf16_f32 %0, %1, %2" : "=v"(r) : "v"(lo), "v"(hi)); return r; }
__device__ __forceinline__ float bf_lo(unsigned w) { return __uint_as_float(w << 16); }
__device__ __forceinline__ float bf_hi(unsigned w) { return __uint_as_float(w & 0xffff0000u); }
__device__ __forceinline__ float sigmoid_f(float v) { return __builtin_amdgcn_rcpf(1.0f + __builtin_amdgcn_exp2f(-1.4426950408889634f * v)); }
__device__ __forceinline__ float gelu_tanh_f(float v) { const float t = v * (1.0f + 0.044715f * v * v); return v * __builtin_amdgcn_rcpf(1.0f + __builtin_amdgcn_exp2f(-2.3022082008f * t)); }
__device__ __forceinline__ float silu_f(float v) { return v * sigmoid_f(v); }
__device__ __forceinline__ u32x4 pack8(f32x4 a, f32x4 b) { u32x4 w; w.x = cvt_pk_bf16(a[0], a[1]); w.y = cvt_pk_bf16(a[2], a[3]); w.z = cvt_pk_bf16(b[0], b[1]); w.w = cvt_pk_bf16(b[2], b[3]); return w; }

struct Epi1 {
    static constexpr bool PERM = true, AFTER_DRAIN = false;
    bf16_t* O; const float* ssq; const float* bgate; const float* qg; const float* kg; PG8_LAS float* xl; const PG8_LAS float* tab; int smask;
    __device__ __forceinline__ void rope_path(const f32x4 (&acc)[2][2][4][2], const Unit& u, int wr, int wc, int fr, int fq, const bool isq) const {
        const int lrow0 = wr * 64 + fr, col0 = u.pn * BM + wc * 32 + 8 * fq;
        float sq[2][4];
#pragma unroll
        for (int ai = 0; ai < 2; ++ai)
#pragma unroll
            for (int m = 0; m < 4; ++m) sq[ai][m] = ssq[u.pm * BM + lrow0 + ai * HALF + m * 16];
        const float* gsrc = (isq ? qg : kg) + 32 * (wc & 1) + 8 * fq;
        const f32x4 g0 = *(const f32x4*)gsrc, g1 = *(const f32x4*)(gsrc + 4);
        const float sc = isq ? QK_C2 : 1.0f;
#pragma unroll
        for (int ai = 0; ai < 2; ++ai)
#pragma unroll
            for (int m = 0; m < 4; ++m) { const float rs2 = 1.0f / (sq[ai][m] * (1.0f / 1024.0f) + EPSN);
#pragma unroll
                for (int bj = 0; bj < 2; ++bj) { if (!isq && bj == 1) continue;
                    const f32x4 a = acc[ai][bj][m][0], b = acc[ai][bj][m][1];
                    float s = ((a[0] * a[0] + a[1] * a[1]) + (a[2] * a[2] + a[3] * a[3])) + ((b[0] * b[0] + b[1] * b[1]) + (b[2] * b[2] + b[3] * b[3]));
                    s += __shfl_xor(s, 16); s += __shfl_xor(s, 32);
                    if (fq == 0) xl[((lrow0 + ai * HALF + m * 16) * 2 + bj) * 4 + wc] = s * rs2; } }
        asm volatile("s_waitcnt lgkmcnt(0)" ::: "memory"); __builtin_amdgcn_s_barrier(); asm volatile("" ::: "memory");
#pragma unroll
        for (int ai = 0; ai < 2; ++ai)
#pragma unroll
            for (int m = 0; m < 4; ++m) {
                const int lrow = lrow0 + ai * HALF + m * 16, grow = u.pm * BM + lrow, t = grow & smask, pos = (wc & 1) ? (t & 63) : (t >> 6);
                const float rs = rsqrtf(sq[ai][m] * (1.0f / 1024.0f) + EPSN);
                const PG8_LAS float* tp = tab + (pos * 16 + 8 * (fq & 1)) * 2;
                const f32x4 c0 = *(const PG8_LAS f32x4*)tp, c1 = *(const PG8_LAS f32x4*)(tp + 4), c2 = *(const PG8_LAS f32x4*)(tp + 8), c3 = *(const PG8_LAS f32x4*)(tp + 12);
                bf16_t* rowp = O + (size_t)grow * PITCH + col0;
#pragma unroll
                for (int bj = 0; bj < 2; ++bj) {
                    if (!isq && bj == 1) { *(u32x4*)(rowp + HALF) = pack8(acc[ai][1][m][0] * rs, acc[ai][1][m][1] * rs); continue; }
                    const PG8_LAS float* xp = xl + ((lrow * 2 + bj) * 4 + (wc & 2));
                    const float hr = rsqrtf((xp[0] + xp[1]) * (1.0f / 64.0f) + EPSN) * rs * sc;
                    f32x4 o0, o1;
#pragma unroll
                    for (int k = 0; k < 8; ++k) {
                        const float y = (k < 4 ? acc[ai][bj][m][0][k & 3] * g0[k & 3] : acc[ai][bj][m][1][k & 3] * g1[k & 3]) * hr;
                        const auto rr = __builtin_amdgcn_permlane32_swap(__float_as_uint(y), __float_as_uint(y), false, false);
                        const float partner = __uint_as_float(fq < 2 ? rr[1] : rr[0]);
                        const f32x4 cs = (k >> 1) == 0 ? c0 : (k >> 1) == 1 ? c1 : (k >> 1) == 2 ? c2 : c3;
                        const float cv = cs[(k & 1) * 2], sv = cs[(k & 1) * 2 + 1];
                        const float r = y * cv + (fq < 2 ? -partner : partner) * sv;
                        if (k < 4) o0[k & 3] = r; else o1[k & 3] = r; }
                    *(u32x4*)(rowp + bj * HALF) = pack8(o0, o1);
                }
            }
    }
    __device__ __forceinline__ void operator()(const f32x4 (&acc)[2][2][4][2], const Unit& u, int wr, int wc, int fr, int fq) const {
        const int row0 = u.pm * BM + wr * 64 + fr, col0 = u.pn * BM + wc * 32 + 8 * fq, pn = u.pn;
        if (pn == 4 || pn == 5 || pn == 9) { rope_path(acc, u, wr, wc, fr, fq, pn != 9); return; }
        const int mode = (pn >= 10) ? 3 : ((pn < 2 || pn == 6 || pn == 7) ? 1 : ((pn == 2 || pn == 3) ? 2 : 0));
        f32x4 bv[2][2];
#pragma unroll
        for (int bj = 0; bj < 2; ++bj)
#pragma unroll
            for (int n = 0; n < 2; ++n) bv[bj][n] = (mode == 3) ? *(const f32x4*)(bgate + (col0 - COL_GATE) + bj * HALF + 4 * n) : (f32x4){0.f, 0.f, 0.f, 0.f};
        float sq[2][4];
#pragma unroll
        for (int ai = 0; ai < 2; ++ai)
#pragma unroll
            for (int m = 0; m < 4; ++m) sq[ai][m] = ssq[row0 + ai * HALF + m * 16];
#pragma unroll
        for (int ai = 0; ai < 2; ++ai)
#pragma unroll
            for (int m = 0; m < 4; ++m) {
                const int row = row0 + ai * HALF + m * 16; const float rs = rsqrtf(sq[ai][m] * (1.0f / 1024.0f) + EPSN);
                bf16_t* rowp = O + (size_t)row * PITCH + col0;
#pragma unroll
                for (int bj = 0; bj < 2; ++bj) {
                    f32x4 v0 = acc[ai][bj][m][0] * rs, v1 = acc[ai][bj][m][1] * rs;
                    if (mode == 1) {
#pragma unroll
                        for (int e = 0; e < 4; ++e) { v0[e] = gelu_tanh_f(v0[e]); v1[e] = gelu_tanh_f(v1[e]); }
                    } else if (mode == 2) { v0 = v0 * QK_C2; v1 = v1 * QK_C2; }
                    else if (mode == 3) { v0 = v0 + bv[bj][0]; v1 = v1 + bv[bj][1];
#pragma unroll
                        for (int e = 0; e < 4; ++e) { v0[e] = sigmoid_f(v0[e]); v1[e] = sigmoid_f(v1[e]); } }
                    *(u32x4*)(rowp + bj * HALF) = pack8(v0, v1);
                }
            }
    }
};

struct Epi4 {
    static constexpr bool PERM = true, AFTER_DRAIN = false;
    bf16_t* HB;
    __device__ __forceinline__ void operator()(const f32x4 (&acc)[2][2][4][2], const Unit& u, int wr, int wc, int fr, int fq) const {
        const int row0 = u.pm * BM + wr * 64 + fr, col0 = u.pn * BM + wc * 32 + 8 * fq;
#pragma unroll
        for (int ai = 0; ai < 2; ++ai) {
            u32x4 gw[4][2], mw[4][2];
#pragma unroll
            for (int m = 0; m < 4; ++m) { const bf16_t* gp = HB + (size_t)(row0 + ai * HALF + m * 16) * PITCH + COL_GATE + u.n * 1024 + col0;
#pragma unroll
                for (int bj = 0; bj < 2; ++bj) gw[m][bj] = *(const u32x4*)(gp + bj * HALF); }
            if (u.n > 0) {
#pragma unroll
                for (int m = 0; m < 4; ++m) { const bf16_t* mp = HB + (size_t)(row0 + ai * HALF + m * 16) * PITCH + COL_MERGED + col0;
#pragma unroll
                    for (int bj = 0; bj < 2; ++bj) mw[m][bj] = *(const u32x4*)(mp + bj * HALF); }
            } else {
#pragma unroll
                for (int m = 0; m < 4; ++m)
#pragma unroll
                    for (int bj = 0; bj < 2; ++bj) mw[m][bj] = (u32x4){0u, 0u, 0u, 0u};
            }
#pragma unroll
            for (int m = 0; m < 4; ++m) { bf16_t* mp = HB + (size_t)(row0 + ai * HALF + m * 16) * PITCH + COL_MERGED + col0;
#pragma unroll
                for (int bj = 0; bj < 2; ++bj) { const u32x4 g = gw[m][bj], w = mw[m][bj];
                    const f32x4 v0 = acc[ai][bj][m][0] * (f32x4){bf_lo(g.x), bf_hi(g.x), bf_lo(g.y), bf_hi(g.y)} + (f32x4){bf_lo(w.x), bf_hi(w.x), bf_lo(w.y), bf_hi(w.y)};
                    const f32x4 v1 = acc[ai][bj][m][1] * (f32x4){bf_lo(g.z), bf_hi(g.z), bf_lo(g.w), bf_hi(g.w)} + (f32x4){bf_lo(w.z), bf_hi(w.z), bf_lo(w.w), bf_hi(w.w)};
                    *(u32x4*)(mp + bj * HALF) = pack8(v0, v1); } }
        }
    }
};

struct Epi5 {
    static constexpr bool PERM = false, AFTER_DRAIN = false;
    const float* xin; float* xout; bf16_t* xb; float* ssq;
    __device__ __forceinline__ void operator()(const f32x4 (&acc)[2][2][4][2], const Unit& u, int wr, int wc, int fr, int fq) const {
        typedef unsigned u32x2v __attribute__((ext_vector_type(2)));
        const int row0 = u.pm * BM + wr * 64 + fr, col0 = u.pn * BM + wc * 32 + 4 * fq;
#pragma unroll
        for (int ai = 0; ai < 2; ++ai) {
            f32x4 xv[4][2][2];
#pragma unroll
            for (int m = 0; m < 4; ++m) { const size_t off = (size_t)(row0 + ai * HALF + m * 16) * DMODEL + col0;
#pragma unroll
                for (int bj = 0; bj < 2; ++bj)
#pragma unroll
                    for (int n = 0; n < 2; ++n) xv[m][bj][n] = *(const f32x4*)(xin + off + bj * HALF + n * 16); }
#pragma unroll
            for (int m = 0; m < 4; ++m) {
                const int row = row0 + ai * HALF + m * 16; const size_t off = (size_t)row * DMODEL + col0; float s = 0.f;
#pragma unroll
                for (int bj = 0; bj < 2; ++bj)
#pragma unroll
                    for (int n = 0; n < 2; ++n) { const size_t c = off + bj * HALF + n * 16; const f32x4 xn = xv[m][bj][n] + acc[ai][bj][m][n]; *(f32x4*)(xout + c) = xn;
                        if (xb) { u32x2v w; w.x = cvt_pk_bf16(xn[0], xn[1]); w.y = cvt_pk_bf16(xn[2], xn[3]); *(u32x2v*)(xb + c) = w; }
                        s += (xn[0] * xn[0] + xn[1] * xn[1]) + (xn[2] * xn[2] + xn[3] * xn[3]); }
                if (ssq) { s += __shfl_xor(s, 16); s += __shfl_xor(s, 32); if (fq == 0) atomicAdd(ssq + row, s); }
            }
        }
    }
};

struct Epi7 {
    static constexpr bool PERM = true, AFTER_DRAIN = false;
    bf16_t* O; const float* ssq; bf16_t* halo;
    __device__ __forceinline__ void operator()(const f32x4 (&acc)[2][2][4][2], const Unit& u, int wr, int wc, int fr, int fq) const {
        const int row0 = u.pm * BM + wr * 64 + fr, col0 = u.pn * BM + wc * 32 + 8 * fq;
#pragma unroll
        for (int ai = 0; ai < 2; ++ai)
#pragma unroll
            for (int m = 0; m < 4; ++m) {
                const int row = row0 + ai * HALF + m * 16; const float rs = rsqrtf(ssq[row] * (1.0f / 1024.0f) + EPSN);
                bf16_t* rowp = O + (size_t)row * PITCH + col0;
                const bool top = (m == 0 && fr == 0), bot = (m == 3 && fr == 15);
                bf16_t* hp = halo + (size_t)((row >> 6) * 2 + (bot ? 1 : 0)) * PITCH + col0;
#pragma unroll
                for (int bj = 0; bj < 2; ++bj) {
                    const u32x4 w = pack8(acc[ai][bj][m][0] * rs, acc[ai][bj][m][1] * rs);
                    *(u32x4*)(rowp + bj * HALF) = w;
                    if (top || bot) *(u32x4*)(hp + bj * HALF) = w;
                }
            }
    }
};

__device__ __forceinline__ float dpp_ror1(float x) { return __int_as_float(__builtin_amdgcn_update_dpp(0, __float_as_int(x), 0x121, 0xf, 0xf, false)); }
__device__ __forceinline__ float dpp_rol1(float x) { return __int_as_float(__builtin_amdgcn_update_dpp(0, __float_as_int(x), 0x12F, 0xf, 0xf, false)); }
struct Epi7f {
    static constexpr bool PERM = true, AFTER_DRAIN = false;
    bf16_t* O; const float* ssq; const float* cw; const float* cb; PG8_LAS float* xl; int smask; int nrows;
    __device__ __forceinline__ void operator()(f32x4 (&acc)[2][2][4][2], const Unit& u, int wr, int wc, int fr, int fq) const {
        typedef unsigned u32x2v __attribute__((ext_vector_type(2)));
        const int lrow0 = wr * 64 + fr, arow = u.arow, olo = u.pm ? 1 : 0;
        float sq[2][4];
#pragma unroll
        for (int ai = 0; ai < 2; ++ai)
#pragma unroll
            for (int m = 0; m < 4; ++m) { int grow = arow + lrow0 + ai * HALF + m * 16; grow = grow < nrows ? grow : nrows - 1; sq[ai][m] = ssq[grow]; }
#pragma unroll
        for (int ai = 0; ai < 2; ++ai)
#pragma unroll
            for (int m = 0; m < 4; ++m) { const float rs = rsqrtf(sq[ai][m] * (1.0f / 1024.0f) + EPSN);
#pragma unroll
                for (int bj = 0; bj < 2; ++bj)
#pragma unroll
                    for (int n = 0; n < 2; ++n) acc[ai][bj][m][n] = acc[ai][bj][m][n] * rs; }
#pragma unroll
        for (int ai = 0; ai < 2; ++ai) { const int blk = 2 * ai + wr;
            if (fr == 15) { PG8_LAS float* p = xl + (((0 * 4 + blk) * 4 + wc) * 4 + fq) * 16;
#pragma unroll
                for (int bj = 0; bj < 2; ++bj)
#pragma unroll
                    for (int n = 0; n < 2; ++n) *(PG8_LAS f32x4*)(p + (bj * 2 + n) * 4) = acc[ai][bj][3][n]; }
            if (fr == 0) { PG8_LAS float* p = xl + (((1 * 4 + blk) * 4 + wc) * 4 + fq) * 16;
#pragma unroll
                for (int bj = 0; bj < 2; ++bj)
#pragma unroll
                    for (int n = 0; n < 2; ++n) *(PG8_LAS f32x4*)(p + (bj * 2 + n) * 4) = acc[ai][bj][0][n]; } }
        asm volatile("s_waitcnt lgkmcnt(0)" ::: "memory"); __builtin_amdgcn_s_barrier(); asm volatile("" ::: "memory");
#pragma unroll
        for (int n = 0; n < 2; ++n) {
            const int cg = u.pn * HALF + wc * 32 + 8 * fq + 4 * n, cv = 2816 + cg;
            const f32x4 wg0 = *(const f32x4*)(cw + cg), wg1 = *(const f32x4*)(cw + 5632 + cg), wg2 = *(const f32x4*)(cw + 2 * 5632 + cg), bg = *(const f32x4*)(cb + cg);
            const f32x4 wv0 = *(const f32x4*)(cw + cv), wv1 = *(const f32x4*)(cw + 5632 + cv), wv2 = *(const f32x4*)(cw + 2 * 5632 + cv), bv = *(const f32x4*)(cb + cv);
#pragma unroll
            for (int ai = 0; ai < 2; ++ai) { const int blk = 2 * ai + wr;
                const PG8_LAS float* pl = xl + (((0 * 4 + (blk > 0 ? blk - 1 : 0)) * 4 + wc) * 4 + fq) * 16;
                const PG8_LAS float* pf = xl + (((1 * 4 + (blk < 3 ? blk + 1 : 3)) * 4 + wc) * 4 + fq) * 16;
#pragma unroll
                for (int m = 0; m < 4; ++m) {
                    const int lrow = lrow0 + ai * HALF + m * 16, grow = arow + lrow;
                    const bool zp = (grow & smask) == 0, zn = ((grow + 1) & smask) == 0;
                    f32x4 hc[2];
#pragma unroll
                    for (int bj = 0; bj < 2; ++bj) {
                        const f32x4 cur = acc[ai][bj][m][n];
                        f32x4 pb, nb;
                        if (m > 0) pb = acc[ai][bj][m - 1][n]; else pb = *(const PG8_LAS f32x4*)(pl + (bj * 2 + n) * 4);
                        if (m < 3) nb = acc[ai][bj][m + 1][n]; else nb = *(const PG8_LAS f32x4*)(pf + (bj * 2 + n) * 4);
                        f32x4 prev, next;
#pragma unroll
                        for (int e = 0; e < 4; ++e) {
                            const float a = dpp_ror1(cur[e]), b = (m > 0) ? dpp_ror1(pb[e]) : pb[e];
                            const float c = dpp_rol1(cur[e]), d = (m < 3) ? dpp_rol1(nb[e]) : nb[e];
                            prev[e] = zp ? 0.f : (fr == 0 ? b : a); next[e] = zn ? 0.f : (fr == 15 ? d : c); }
                        hc[bj] = bj == 0 ? prev * wg0 + cur * wg1 + next * wg2 + bg : prev * wv0 + cur * wv1 + next * wv2 + bv;
                    }
                    if (lrow >= olo && lrow <= olo + 253 && grow < nrows) {
                        u32x2v w; w.x = cvt_pk_bf16(silu_f(hc[0][0]) * hc[1][0], silu_f(hc[0][1]) * hc[1][1]); w.y = cvt_pk_bf16(silu_f(hc[0][2]) * hc[1][2], silu_f(hc[0][3]) * hc[1][3]);
                        *(u32x2v*)(O + (size_t)grow * PITCH + cg) = w; }
                }
            }
        }
    }
};

template <class Epi, class Sched, bool ALIGN_EPI = false, bool SP2 = false>
__device__ __forceinline__ void gemm_phase(PG8_LAS unsigned char* lds, const Gemm g, const Sched& S, const Epi& E, const int tid_in) {
    int tid = tid_in; asm volatile("" : "+v"(tid)); const int wid = __builtin_amdgcn_readfirstlane(tid >> 6), lane = tid & 63, wr = wid >> 2, wc = wid & 3, fr = lane & 15, fq = lane >> 4;
    const int K = g.K, nt = K / BK;
    unsigned voffA[2], voffB[2];
#pragma unroll
    for (int i = 0; i < 2; ++i) { int R, C; stage_rc(tid * 16 + i * 8192, R, C); const int Rb = Epi::PERM ? ((R & ~31) + perm32(R & 31)) : R;
        voffA[i] = (unsigned)(R * g.lda + C) * 2u; voffB[i] = (unsigned)(Rb * g.ldb + C) * 2u; }
    const size_t kstep = (size_t)(BK * 2);
    const size_t hstepA = (size_t)HALF * g.lda * 2, hstepB = (size_t)HALF * g.ldb * 2;
    const size_t tstepB = 2 * hstepB;
    const unsigned ldsw = (unsigned)wid * 1024u;
    const int aoff = lds_byte(wr * 64 + fr, fq * 8), boff = lds_byte(wc * 32 + fr, fq * 8);
#define PG8_SA(b, h) (((b) * 2 + (h)) * HTB)
#define PG8_SB(b, h) ((4 + (b) * 2 + (h)) * HTB)
#define PG8_STAGE(bufoff, gbase, voff) do { _Pragma("unroll") for (int _i = 0; _i < 2; ++_i) \
        __builtin_amdgcn_global_load_lds((const unsigned*)((const char*)(gbase) + (voff)[_i]), (PG8_LAS unsigned*)(lds + (bufoff) + ldsw + _i * 8192), 16, 0, 0); } while (0)
#define PG8_LDA(dst, b, h) do { _Pragma("unroll") for (int m = 0; m < 4; ++m) _Pragma("unroll") for (int k = 0; k < 2; ++k) dst[m][k] = *(const PG8_LAS bf16x8*)(lds + PG8_SA(b, h) + aoff + m * 2048 + k * 1024); } while (0)
#define PG8_LDB(dst, b, h) do { _Pragma("unroll") for (int n = 0; n < 2; ++n) _Pragma("unroll") for (int k = 0; k < 2; ++k) dst[n][k] = *(const PG8_LAS bf16x8*)(lds + PG8_SB(b, h) + boff + n * 2048 + k * 1024); } while (0)
#define PG8_MMA(ai, bj, At, Bt) do { __builtin_amdgcn_s_setprio(1); _Pragma("unroll") for (int m = 0; m < 4; ++m) _Pragma("unroll") for (int n = 0; n < 2; ++n) _Pragma("unroll") for (int k = 0; k < 2; ++k) \
        acc[ai][bj][m][n] = __builtin_amdgcn_mfma_f32_16x16x32_bf16(Bt[n][k], At[m][k], acc[ai][bj][m][n], 0, 0, 0); __builtin_amdgcn_s_setprio(0); } while (0)
#define PG8_WAIT_V(n) asm volatile("s_waitcnt vmcnt(" #n ")" ::: "memory")
#define PG8_WAIT_L(n) asm volatile("s_waitcnt lgkmcnt(" #n ")" ::: "memory")
#define PG8_BAR __builtin_amdgcn_s_barrier()
#define PG8_SCHED __builtin_amdgcn_sched_barrier(0)
    Unit cur, nxt; int ui = 0;
    if (!S.next(0, cur)) return;
    f32x4 acc[2][2][4][2];
#pragma unroll
    for (int a = 0; a < 2; ++a)
#pragma unroll
        for (int b = 0; b < 2; ++b)
#pragma unroll
            for (int m = 0; m < 4; ++m)
#pragma unroll
                for (int n = 0; n < 2; ++n) acc[a][b][m][n] = (f32x4){0.f, 0.f, 0.f, 0.f};
    bf16x8 At[4][2], B0[2][2], B1[2][2];
    const char* cA = (const char*)g.A + (size_t)cur.arow * (size_t)g.lda * 2 + (size_t)cur.ko * 2; const char* cB = (const char*)g.Bt + (size_t)cur.pn * tstepB + (size_t)cur.ko * 2;
    S.a_ready(cur);
    if constexpr (SP2) {
        PG8_STAGE(PG8_SB(0, 0), cB, voffB); PG8_STAGE(PG8_SB(0, 1), cB + hstepB, voffB); PG8_STAGE(PG8_SA(0, 0), cA, voffA); PG8_STAGE(PG8_SA(0, 1), cA + hstepA, voffA);
        if (wr == 1) PG8_BAR;
        PG8_WAIT_V(2); PG8_BAR;
        PG8_STAGE(PG8_SB(1, 0), cB + kstep, voffB); PG8_STAGE(PG8_SA(1, 0), cA + kstep, voffA); PG8_STAGE(PG8_SB(1, 1), cB + hstepB + kstep, voffB);
        PG8_WAIT_V(6); PG8_BAR;
    } else {
        PG8_STAGE(PG8_SB(0, 0), cB, voffB); PG8_STAGE(PG8_SA(0, 0), cA, voffA); PG8_STAGE(PG8_SB(0, 1), cB + hstepB, voffB); PG8_STAGE(PG8_SA(0, 1), cA + hstepA, voffA);
        if (wr == 1) PG8_BAR;
        PG8_WAIT_V(4); PG8_BAR;
        PG8_STAGE(PG8_SB(1, 0), cB + kstep, voffB); PG8_STAGE(PG8_SA(1, 0), cA + kstep, voffA); PG8_STAGE(PG8_SB(1, 1), cB + hstepB + kstep, voffB);
        PG8_WAIT_V(6); PG8_BAR;
    }
    for (;;) {
        const bool has_next = S.next(ui + 1, nxt);
        const char* nA = has_next ? (const char*)g.A + (size_t)nxt.arow * (size_t)g.lda * 2 + (size_t)nxt.ko * 2 : cA; const char* nB = has_next ? (const char*)g.Bt + (size_t)nxt.pn * tstepB + (size_t)nxt.ko * 2 : cB;
        for (int t = 0; t < nt; t += 2) {
            const bool last = (t == nt - 2);
            const char* a1 = cA + (size_t)(t + 1) * kstep;
            const char* a2 = last ? nA : cA + (size_t)(t + 2) * kstep; const char* b2 = last ? nB : cB + (size_t)(t + 2) * kstep;
            const char* a3 = a2 + kstep; const char* b3 = b2 + kstep;
            if (last && has_next) S.a_ready(nxt);
            if constexpr (SP2) {
            PG8_LDB(B0, 0, 0); PG8_LDB(B1, 0, 1); PG8_SCHED; PG8_LDA(At, 0, 0); PG8_STAGE(PG8_SA(1, 1), a1 + hstepA, voffA);
            PG8_WAIT_V(8); PG8_WAIT_L(0); PG8_BAR; PG8_MMA(0, 0, At, B0); PG8_MMA(0, 1, At, B1); PG8_BAR; PG8_SCHED;
            PG8_LDA(At, 0, 1); PG8_STAGE(PG8_SB(0, 0), b2, voffB); PG8_STAGE(PG8_SB(0, 1), b2 + hstepB, voffB); PG8_STAGE(PG8_SA(0, 0), a2, voffA);
            PG8_WAIT_V(8); PG8_WAIT_L(0); PG8_BAR; PG8_MMA(1, 0, At, B0); PG8_MMA(1, 1, At, B1); PG8_BAR; PG8_SCHED;
            PG8_LDB(B0, 1, 0); PG8_LDB(B1, 1, 1); PG8_SCHED; PG8_LDA(At, 1, 0); PG8_STAGE(PG8_SA(0, 1), a2 + hstepA, voffA);
            PG8_WAIT_V(8); PG8_WAIT_L(0); PG8_BAR; PG8_MMA(0, 0, At, B0); PG8_MMA(0, 1, At, B1); PG8_BAR; PG8_SCHED;
            PG8_LDA(At, 1, 1); PG8_STAGE(PG8_SB(1, 0), b3, voffB); PG8_STAGE(PG8_SB(1, 1), b3 + hstepB, voffB); PG8_STAGE(PG8_SA(1, 0), a3, voffA);
            PG8_WAIT_V(8); PG8_WAIT_L(0); PG8_BAR; PG8_MMA(1, 0, At, B0); PG8_MMA(1, 1, At, B1); PG8_BAR; PG8_SCHED;
            } else {
            PG8_LDB(B0, 0, 0); PG8_SCHED; PG8_LDA(At, 0, 0); PG8_STAGE(PG8_SA(1, 1), a1 + hstepA, voffA);
            PG8_WAIT_L(8); PG8_BAR; PG8_WAIT_L(0); PG8_MMA(0, 0, At, B0); PG8_BAR; PG8_SCHED;
            PG8_LDB(B1, 0, 1); PG8_STAGE(PG8_SB(0, 0), b2, voffB);
            PG8_BAR; PG8_WAIT_L(0); PG8_MMA(0, 1, At, B1); PG8_BAR;
            PG8_LDA(At, 0, 1); PG8_STAGE(PG8_SA(0, 0), a2, voffA);
            PG8_BAR; PG8_WAIT_L(0); PG8_MMA(1, 0, At, B0); PG8_BAR; PG8_SCHED;
            PG8_STAGE(PG8_SB(0, 1), b2 + hstepB, voffB);
            PG8_WAIT_V(6); PG8_BAR; PG8_MMA(1, 1, At, B1); PG8_BAR;
            PG8_LDB(B0, 1, 0); PG8_SCHED; PG8_LDA(At, 1, 0); PG8_STAGE(PG8_SA(0, 1), a2 + hstepA, voffA);
            PG8_WAIT_L(8); PG8_BAR; PG8_WAIT_L(0); PG8_MMA(0, 0, At, B0); PG8_BAR; PG8_SCHED;
            PG8_LDB(B1, 1, 1); PG8_STAGE(PG8_SB(1, 0), b3, voffB);
            PG8_BAR; PG8_WAIT_L(0); PG8_MMA(0, 1, At, B1); PG8_BAR;
            PG8_LDA(At, 1, 1); PG8_STAGE(PG8_SA(1, 0), a3, voffA);
            PG8_BAR; PG8_WAIT_L(0); PG8_MMA(1, 0, At, B0); PG8_BAR; PG8_SCHED;
            PG8_STAGE(PG8_SB(1, 1), b3 + hstepB, voffB);
            PG8_WAIT_V(6); PG8_BAR; PG8_MMA(1, 1, At, B1); PG8_BAR;
            }
        }
        if constexpr (ALIGN_EPI) { if (wr == 0) PG8_BAR; }
        if constexpr (!Epi::AFTER_DRAIN) { E(acc, cur, wr, wc, fr, fq); S.done(cur); }
        if (!has_next) break;
#pragma unroll
        for (int a = 0; a < 2; ++a)
#pragma unroll
            for (int b = 0; b < 2; ++b)
#pragma unroll
                for (int m = 0; m < 4; ++m)
#pragma unroll
                    for (int n = 0; n < 2; ++n) acc[a][b][m][n] = (f32x4){0.f, 0.f, 0.f, 0.f};
        cur = nxt; cA = nA; cB = nB; ++ui;
        if constexpr (ALIGN_EPI) { if (wr == 1) PG8_BAR; }
    }
    PG8_WAIT_V(0);
    if constexpr (!ALIGN_EPI) { if (wr == 0) PG8_BAR; }
    PG8_BAR;
    if constexpr (Epi::AFTER_DRAIN) { E.fused(acc, cur, wr, wc, fr, fq, lds, wid, lane); S.done(cur); }
#undef PG8_SA
#undef PG8_SB
#undef PG8_STAGE
#undef PG8_LDA
#undef PG8_LDB
#undef PG8_MMA
#undef PG8_WAIT_V
#undef PG8_WAIT_L
#undef PG8_BAR
#undef PG8_SCHED
}
}
namespace attn_body {
using bf16=__hip_bfloat16;
using bf16x8=__attribute__((ext_vector_type(8)))short;
using s16x4=__attribute__((ext_vector_type(4)))short;
using f32x16=__attribute__((ext_vector_type(16)))float;
using u32x4=__attribute__((ext_vector_type(4)))unsigned;
constexpr int D=64,DM=5632;
constexpr int NW=8,QBLK=32,QB=QBLK*NW,KVBLK=64;
constexpr int ATTN_PITCH=DM, ATTN_UNIT_ROWS=QB;
__device__ __forceinline__ int crow(int r,int hi){return (r&3)+8*(r>>2)+4*hi;}
#define SBAR() __builtin_amdgcn_sched_barrier(0)
__device__ __forceinline__ void cmask(f32x16&p0,f32x16&p1,int jb,int qrel,int hi){
  const float NEG=-INFINITY; int kb=64*jb+4*hi;
  #pragma unroll
  for(int r=0;r<16;++r){int kv=kb+(r&3)+8*(r>>2); if(kv>qrel)p0[r]=NEG; if(kv+32>qrel)p1[r]=NEG;}
}

typedef __attribute__((address_space(3))) const float* lds_fptr;
__device__ __forceinline__ void bmask(f32x16&p0,f32x16&p1,int rel0,lds_fptr tab){
  float bb[16];
  #pragma unroll
  for(int r=0;r<16;++r){ const int rel=rel0+(r&3)+8*(r>>2); bb[r]=tab[min(max(rel+128,0),256)]; }
  __builtin_amdgcn_sched_barrier(0);
  #pragma unroll
  for(int r=0;r<16;++r){ const int rel=rel0+(r&3)+8*(r>>2); p0[r]=((unsigned)(rel+128)<=256u)?p0[r]+bb[r]:-1000.f; }
  __builtin_amdgcn_sched_barrier(0);
  #pragma unroll
  for(int r=0;r<16;++r){ const int rel=rel0+32+(r&3)+8*(r>>2); bb[r]=tab[min(max(rel+128,0),256)]; }
  __builtin_amdgcn_sched_barrier(0);
  #pragma unroll
  for(int r=0;r<16;++r){ const int rel=rel0+32+(r&3)+8*(r>>2); p1[r]=((unsigned)(rel+128)<=256u)?p1[r]+bb[r]:-1000.f; }
}
constexpr int NSLOT=3, SLOTB=8192;
constexpr int LDS_K=0, LDS_V=NSLOT*SLOTB, LDS_WS=2*NSLOT*SLOTB, LDS_OST=LDS_WS+NW*64*4, LDS_BYTES=LDS_OST+NW*4096;
constexpr float C2=0.125f*1.4426950408889634f;
__device__ __forceinline__ void glds16(const void*gsrc,unsigned lds_dst){unsigned keep;
  asm volatile("s_mov_b32 %0, m0\n\ts_mov_b32 m0, %2\n\ts_nop 0\n\tglobal_load_lds_dwordx4 %1, off\n\ts_mov_b32 m0, %0":"=&s"(keep):"v"(gsrc),"s"(lds_dst):"memory");}
__device__ __forceinline__ float max3f(float a,float b,float c){float r;asm("v_max3_f32 %0, %1, %2, %3":"=v"(r):"v"(a),"v"(b),"v"(c));return r;}
__device__ __forceinline__ float max2f(float a,float b){float r;asm("v_max_f32_e32 %0, %1, %2":"=v"(r):"v"(a),"v"(b));return r;}
__device__ __forceinline__ float fadd_s(float a,float b){float r;asm("v_add_f32_e32 %0, %1, %2":"=v"(r):"v"(a),"v"(b));return r;}
__device__ __forceinline__ float fsub_s(float a,float b){float r;asm("v_sub_f32_e32 %0, %1, %2":"=v"(r):"v"(a),"v"(b));return r;}
typedef float f32x2_t __attribute__((ext_vector_type(2))); typedef __bf16 bf16x2_t __attribute__((ext_vector_type(2)));
__device__ __forceinline__ unsigned cvtpk_s(float lo,float hi){f32x2_t v={lo,hi};bf16x2_t b=__builtin_convertvector(v,bf16x2_t);return __builtin_bit_cast(unsigned,b);}
#define WAIT_BAR(N) asm volatile("s_waitcnt vmcnt(" #N ") lgkmcnt(0)\n\ts_barrier":::"memory")

__device__ __forceinline__ void qkt(f32x16&p0,f32x16&p1,const char*Kslot,const bf16x8*qr,const f32x16&negm,int r32,int hi){
  const char*kb=Kslot+hi*1024+r32*16;
  #pragma unroll
  for(int d0=0;d0<4;++d0){
    const bf16x8 b0=*reinterpret_cast<const bf16x8*>(kb+d0*2048);
    const bf16x8 b1=*reinterpret_cast<const bf16x8*>(kb+d0*2048+512);
    if(d0==0){p0=__builtin_amdgcn_mfma_f32_32x32x16_bf16(b0,qr[0],negm,0,0,0);p1=__builtin_amdgcn_mfma_f32_32x32x16_bf16(b1,qr[0],negm,0,0,0);}
    else{p0=__builtin_amdgcn_mfma_f32_32x32x16_bf16(b0,qr[d0],p0,0,0,0);p1=__builtin_amdgcn_mfma_f32_32x32x16_bf16(b1,qr[d0],p1,0,0,0);}}
}
typedef __attribute__((address_space(3))) const char* lds_cptr;
typedef short v4i16_t __attribute__((ext_vector_type(4)));
__device__ __forceinline__ void kload8(bf16x8*kf,lds_cptr kp){
  kf[0]=*(const __attribute__((address_space(3))) bf16x8*)(kp);      kf[1]=*(const __attribute__((address_space(3))) bf16x8*)(kp+512);
  kf[2]=*(const __attribute__((address_space(3))) bf16x8*)(kp+2048); kf[3]=*(const __attribute__((address_space(3))) bf16x8*)(kp+2560);
  kf[4]=*(const __attribute__((address_space(3))) bf16x8*)(kp+4096); kf[5]=*(const __attribute__((address_space(3))) bf16x8*)(kp+4608);
  kf[6]=*(const __attribute__((address_space(3))) bf16x8*)(kp+6144); kf[7]=*(const __attribute__((address_space(3))) bf16x8*)(kp+6656);
}
__device__ __forceinline__ void kload2(bf16x8*kf,lds_cptr kp,int j){ kf[2*j]=*(const __attribute__((address_space(3))) bf16x8*)(kp+j*2048); kf[2*j+1]=*(const __attribute__((address_space(3))) bf16x8*)(kp+j*2048+512); }
__device__ __forceinline__ s16x4 vtr(lds_cptr p){ return __builtin_bit_cast(s16x4,__builtin_amdgcn_ds_read_tr16_b64_v4i16((__attribute__((address_space(3))) v4i16_t*)p)); }
__device__ __forceinline__ float rowmax(const f32x16&p0,const f32x16&p1){
  float a=max3f(p0[0],p0[1],p1[0]),b=max3f(p0[2],p0[3],p1[1]);a=max3f(a,p1[2],p1[3]);
  #pragma unroll
  for(int r=4;r<16;r+=4){a=max3f(a,p0[r],p0[r+1]);b=max3f(b,p0[r+2],p0[r+3]);a=max3f(a,p1[r],p1[r+1]);b=max3f(b,p1[r+2],p1[r+3]);}
  const float m=max2f(a,b);
  auto rr=__builtin_amdgcn_permlane32_swap(__float_as_uint(m),__float_as_uint(m),false,false);
  return max2f(__uint_as_float(rr[0]),__uint_as_float(rr[1]));
}
__device__ __forceinline__ void pv(f32x16*o,int vb,bf16x8 pa0,bf16x8 pa1,bf16x8 pa2,bf16x8 pa3){
  #pragma unroll
  for(int d0=0;d0<2;++d0){s16x4 lo[4],hi[4];
    #pragma unroll
    for(int ks=0;ks<4;++ks){
      asm volatile("ds_read_b64_tr_b16 %0,%1 offset:%c2":"=&v"(lo[ks]):"v"(vb),"i"(d0*4096+ks*1024):"memory");
      asm volatile("ds_read_b64_tr_b16 %0,%1 offset:%c2":"=&v"(hi[ks]):"v"(vb),"i"(d0*4096+ks*1024+512):"memory");}
    asm volatile("s_waitcnt lgkmcnt(0)":::"memory");SBAR();
    #define PK(k) (bf16x8){lo[k][0],lo[k][1],lo[k][2],lo[k][3],hi[k][0],hi[k][1],hi[k][2],hi[k][3]}
    o[d0]=__builtin_amdgcn_mfma_f32_32x32x16_bf16(pa0,PK(0),o[d0],0,0,0);
    o[d0]=__builtin_amdgcn_mfma_f32_32x32x16_bf16(pa1,PK(1),o[d0],0,0,0);
    o[d0]=__builtin_amdgcn_mfma_f32_32x32x16_bf16(pa2,PK(2),o[d0],0,0,0);
    o[d0]=__builtin_amdgcn_mfma_f32_32x32x16_bf16(pa3,PK(3),o[d0],0,0,0);
    #undef PK
  }
}

#ifndef ATTN_STORE16
#define ATTN_STORE16(p,v) (*(u32x4*)(p)=(v))
#endif
template<int THRL,int MODE> __device__ __forceinline__ void attn_unit(long rowbase,int q0,int kt0,int NT,const bf16*Q,const bf16*__restrict__ K,const bf16*__restrict__ V,bf16*O,char*shm,lds_fptr btab,float sinkl2,const int tid_in){
  int tid=tid_in; asm volatile("":"+v"(tid)); const int lane=tid&63,r32=lane&31,hi=lane>>5; const int wid=__builtin_amdgcn_readfirstlane(tid>>6);
    const bf16*Qw=Q+(rowbase+q0+wid*QBLK)*DM;
  const bf16*Kh=K+(rowbase+kt0)*DM,*Vh=V+(rowbase+kt0)*DM;
  const unsigned lds0=(unsigned)(uintptr_t)shm;
  float*wsf=(float*)(shm+LDS_WS)+wid*64;
  const bf16*ksrc=Kh+(long)lane*DM+wid*8;
  const bf16*vsrc=Vh+(long)(16*(wid&3)+(lane>>2))*DM+(wid>>2)*32+(lane&3)*8;
  const unsigned kdst=lds0+LDS_K+wid*1024, vdst=lds0+LDS_V+wid*1024;
  #define DMA_K(t,slot) glds16(ksrc+(long)(t)*KVBLK*DM,(unsigned)__builtin_amdgcn_readfirstlane(kdst+(slot)))
  #define DMA_V(t,slot) glds16(vsrc+(long)(t)*KVBLK*DM,(unsigned)__builtin_amdgcn_readfirstlane(vdst+(slot)))
  const int vb0=(int)(lds0+LDS_V)+((lane>>4)&1)*32+(lane&3)*8+(4*hi+((lane&15)>>2))*64;
  const char*Kbase=shm+LDS_K; bf16x8 kf[8];
  const lds_cptr shm3=(lds_cptr)shm; const lds_cptr kp0=shm3+LDS_K+hi*1024+r32*16; const lds_cptr vp0=shm3+LDS_V+((lane>>4)&1)*32+(lane&3)*8+(4*hi+((lane&15)>>2))*64;
  DMA_K(0,0);DMA_V(0,0);DMA_K(1,SLOTB);
  bf16x8 qr[4];
  #pragma unroll
  for(int d0=0;d0<4;++d0)qr[d0]=*reinterpret_cast<const bf16x8*>(&Qw[(long)r32*DM+d0*16+hi*8]);
  float mhat=0.f,l_reg=0.f;f32x16 o[2];o[0]=f32x16{};o[1]=f32x16{};f32x16 negm=f32x16{};asm volatile("":"+v"(negm));
  const int qrel=wid*QBLK+r32;
  #define CMASK(P0,P1,t) do{ if(MODE==1) bmask(P0,P1,kt0+64*(t)+4*hi-(q0+qrel),btab); }while(0)
  bool resc=false;
  #define START(P0,P1) do{ const float rm=rowmax(P0,P1); resc=false; \
    { const float dl=rm; mhat=fadd_s(mhat,dl); \
      _Pragma("unroll") for(int r=0;r<16;++r){P0[r]=fsub_s(P0[r],dl);P1[r]=fsub_s(P1[r],dl);} \
      _Pragma("unroll") for(int r=0;r<16;++r)negm[r]=-mhat; asm volatile("":"+v"(negm)); } \
    _Pragma("unroll") for(int r=0;r<16;++r)P0[r]=__builtin_amdgcn_exp2f(P0[r]); }while(0)
  #define RESC() do{ if(resc){ asm volatile("s_waitcnt lgkmcnt(0)":::"memory"); \
      _Pragma("unroll") for(int d_=0;d_<2;++d_) _Pragma("unroll") for(int r=0;r<16;++r)o[d_][r]*=wsf[crow(r,hi)]; } }while(0)
  f32x16 pA0,pA1,pB0,pB1;
  int sl_prev=0,sl_cur=0,sl_next=SLOTB;
  #define ROT() do{sl_prev=sl_cur;sl_cur=sl_next;sl_next=(sl_next==(NSLOT-1)*SLOTB)?0:sl_next+SLOTB;}while(0)
  DMA_K(2,2*SLOTB);
  WAIT_BAR(3);
  qkt(pA0,pA1,Kbase,qr,negm,r32,hi);asm volatile("s_nop 15\n\ts_nop 7":"+v"(pA0),"+v"(pA1));CMASK(pA0,pA1,0);
  START(pA0,pA1);
  _Pragma("unroll") for(int r=0;r<16;++r)pA1[r]=__builtin_amdgcn_exp2f(pA1[r]);
  WAIT_BAR(0);
  DMA_K(3,0);DMA_V(1,SLOTB);
  ROT();
  kload8(kf,kp0+sl_cur);
  WAIT_BAR(2);
  s16x4 vlo[8],vhi[8]; u32x4 pw0,pw1,pw2,pw3;
  #define PKW(P,B) cvtpk_s(P[B],P[B+1])
  #define PAF(k) __builtin_bit_cast(bf16x8,pw##k)
  #define VFR(i) (bf16x8){vlo[i][0],vlo[i][1],vlo[i][2],vlo[i][3],vhi[i][0],vhi[i][1],vhi[i][2],vhi[i][3]}
  #define PIN(x) asm volatile("":"+v"(x))
  #define MX3(a,b,c) __builtin_fmaxf(__builtin_fmaxf((a),(b)),(c))
  #define GAPA(MF,A0,A1,A2,A3,W0,W1,PW) do{ MF; sacc+=A0; sacc+=A1; sacc+=A2; sacc+=A3; PIN(sacc); W0; W1; PIN(PW); SBAR(); }while(0)
  #define EX(v) __builtin_amdgcn_exp2f(v)
  #define GAPB(MF,X,B) do{ MF; X[B]=EX(X[B]); X[B+1]=EX(X[B+1]); X[B+2]=EX(X[B+2]); X[B+3]=EX(X[B+3]); PIN(X); SBAR(); }while(0)
  #define VRD(i) do{ vlo[i]=vtr(vp_+(((i)>>2)*4096+((i)&3)*1024)); vhi[i]=vtr(vp_+(((i)>>2)*4096+((i)&3)*1024+512)); }while(0)
  #define KRD(G,j) do{ if(G){ kload2(kf,kp0+sl_next,j); SBAR(); } }while(0)
  #define STEP(C0,C1,P0,P1,t,GK,GV,GL) do{ SBAR(); \
    const lds_cptr vp_=vp0+sl_prev; \
    VRD(0); SBAR(); float sacc=(P0[0]+P0[1]); \
    GAPA(C0=__builtin_amdgcn_mfma_f32_32x32x16_bf16(kf[0],qr[0],negm,0,0,0), P0[2],P0[3],P0[4],P0[5],     pw0[0]=PKW(P0,0), pw0[1]=PKW(P0,2), pw0); \
    VRD(4); SBAR(); GAPA(C1=__builtin_amdgcn_mfma_f32_32x32x16_bf16(kf[1],qr[0],negm,0,0,0), P0[6],P0[7],P0[8],P0[9],     pw0[2]=PKW(P0,4), pw0[3]=PKW(P0,6), pw0); \
    VRD(1); SBAR(); GAPA(C0=__builtin_amdgcn_mfma_f32_32x32x16_bf16(kf[2],qr[1],C0,0,0,0),   P0[10],P0[11],P0[12],P0[13], pw1[0]=PKW(P0,8), pw1[1]=PKW(P0,10), pw1); \
    VRD(5); SBAR(); GAPA(C1=__builtin_amdgcn_mfma_f32_32x32x16_bf16(kf[3],qr[1],C1,0,0,0),   P0[14],P0[15],P1[0],P1[1],   pw1[2]=PKW(P0,12),pw1[3]=PKW(P0,14), pw1); \
    VRD(2); SBAR(); GAPA(C0=__builtin_amdgcn_mfma_f32_32x32x16_bf16(kf[4],qr[2],C0,0,0,0),   P1[2],P1[3],P1[4],P1[5],     pw2[0]=PKW(P1,0), pw2[1]=PKW(P1,2), pw2); \
    VRD(6); SBAR(); GAPA(C1=__builtin_amdgcn_mfma_f32_32x32x16_bf16(kf[5],qr[2],C1,0,0,0),   P1[6],P1[7],P1[8],P1[9],     pw2[2]=PKW(P1,4), pw2[3]=PKW(P1,6), pw2); \
    VRD(3); SBAR(); GAPA(C0=__builtin_amdgcn_mfma_f32_32x32x16_bf16(kf[6],qr[3],C0,0,0,0),   P1[10],P1[11],P1[12],P1[13], pw3[0]=PKW(P1,8), pw3[1]=PKW(P1,10), pw3); \
    VRD(7); SBAR(); GAPA(C1=__builtin_amdgcn_mfma_f32_32x32x16_bf16(kf[7],qr[3],C1,0,0,0),   P1[14],P1[15],0.f,0.f,       pw3[2]=PKW(P1,12),pw3[3]=PKW(P1,14), pw3); \
    l_reg+=sacc; \
    if(GK){DMA_K((t)+3,sl_cur);} if(GV){DMA_V((t)+1,sl_next);} \
    CMASK(C0,C1,t); \
    { float a=MX3(C0[0],C0[1],C1[0]),b=MX3(C0[2],C0[3],C1[1]); a=MX3(a,C1[2],C1[3]); \
      _Pragma("unroll") for(int r=4;r<16;r+=4){a=MX3(a,C0[r],C0[r+1]);b=MX3(b,C0[r+2],C0[r+3]);a=MX3(a,C1[r],C1[r+1]);b=MX3(b,C1[r+2],C1[r+3]);} \
      float rm=__builtin_fmaxf(a,b); { auto rr=__builtin_amdgcn_permlane32_swap(__float_as_uint(rm),__float_as_uint(rm),false,false); rm=__builtin_fmaxf(__uint_as_float(rr[0]),__uint_as_float(rr[1])); } \
      resc=false; \
      if(__builtin_expect(__any(rm>(float)THRL),0)){ const float dl=__builtin_fmaxf(rm,0.f); mhat+=dl; \
        _Pragma("unroll") for(int r=0;r<16;++r){C0[r]-=dl;C1[r]-=dl;} \
        _Pragma("unroll") for(int r=0;r<16;++r)negm[r]=-mhat; asm volatile("":"+v"(negm)); \
        const float f=__builtin_amdgcn_exp2f(-dl); l_reg*=f; if(hi==0)wsf[r32]=f; resc=true; } } \
    SBAR(); \
    GAPB(o[0]=__builtin_amdgcn_mfma_f32_32x32x16_bf16(PAF(0),VFR(0),o[0],0,0,0), C0,0); \
    GAPB(o[1]=__builtin_amdgcn_mfma_f32_32x32x16_bf16(PAF(0),VFR(4),o[1],0,0,0), C0,4); \
    KRD(GL,0); GAPB(o[0]=__builtin_amdgcn_mfma_f32_32x32x16_bf16(PAF(1),VFR(1),o[0],0,0,0), C0,8); \
    KRD(GL,1); GAPB(o[1]=__builtin_amdgcn_mfma_f32_32x32x16_bf16(PAF(1),VFR(5),o[1],0,0,0), C0,12); \
    KRD(GL,2); GAPB(o[0]=__builtin_amdgcn_mfma_f32_32x32x16_bf16(PAF(2),VFR(2),o[0],0,0,0), C1,0); \
    KRD(GL,3); GAPB(o[1]=__builtin_amdgcn_mfma_f32_32x32x16_bf16(PAF(2),VFR(6),o[1],0,0,0), C1,4); \
    GAPB(o[0]=__builtin_amdgcn_mfma_f32_32x32x16_bf16(PAF(3),VFR(3),o[0],0,0,0), C1,8); \
    GAPB(o[1]=__builtin_amdgcn_mfma_f32_32x32x16_bf16(PAF(3),VFR(7),o[1],0,0,0), C1,12); \
    }while(0)
  int t=1;
  for(;t+5<NT;t+=2){
    STEP(pB0,pB1,pA0,pA1,t,true,true,true);     WAIT_BAR(2); RESC(); ROT();
    STEP(pA0,pA1,pB0,pB1,t+1,true,true,true);   WAIT_BAR(2); RESC(); ROT();
  }
  #define ENDW(tt) do{ if((tt)+3<NT){WAIT_BAR(2);} else if((tt)+2<NT){WAIT_BAR(1);} else {WAIT_BAR(0);} }while(0)
  for(;t+1<NT;t+=2){
    STEP(pB0,pB1,pA0,pA1,t,(t+3<NT),(t+1<NT),(t+1<NT));       ENDW(t);   RESC(); ROT();
    STEP(pA0,pA1,pB0,pB1,t+1,(t+4<NT),(t+2<NT),(t+2<NT));     ENDW(t+1); RESC(); ROT();
  }
  STEP(pB0,pB1,pA0,pA1,NT-1,false,false,false); RESC();
  { float sacc=pB0[0]+pB0[1]; _Pragma("unroll") for(int r=2;r<16;++r)sacc+=pB0[r]; _Pragma("unroll") for(int r=0;r<16;++r)sacc+=pB1[r]; l_reg+=sacc;
    pw0=(u32x4){PKW(pB0,0),PKW(pB0,2),PKW(pB0,4),PKW(pB0,6)};pw1=(u32x4){PKW(pB0,8),PKW(pB0,10),PKW(pB0,12),PKW(pB0,14)};pw2=(u32x4){PKW(pB1,0),PKW(pB1,2),PKW(pB1,4),PKW(pB1,6)};pw3=(u32x4){PKW(pB1,8),PKW(pB1,10),PKW(pB1,12),PKW(pB1,14)};
    SBAR(); pv(o,vb0+sl_cur,PAF(0),PAF(1),PAF(2),PAF(3)); }
  #undef PKW
  #undef PAF
  #undef VFR
  #undef PIN
  #undef MX3
  #undef GAPA
  #undef GAPB
  #undef EX
  #undef VRD
  #undef KRD
  #undef STEP
  #undef ENDW
  {auto rr=__builtin_amdgcn_permlane32_swap(__float_as_uint(l_reg),__float_as_uint(l_reg),false,false);l_reg=__uint_as_float(rr[0])+__uint_as_float(rr[1]);}
  if(MODE==1) l_reg+=__builtin_amdgcn_exp2f(sinkl2-mhat);
  if(hi==0)wsf[32+r32]=l_reg;asm volatile("s_waitcnt lgkmcnt(0)":::"memory");
  float rli[16];
  #pragma unroll
  for(int r=0;r<16;++r)rli[r]=__builtin_amdgcn_rcpf(wsf[32+crow(r,hi)]);
  bf16*Ow=O+(rowbase+q0+wid*QBLK)*DM;
  { bf16*stg=(bf16*)(shm+LDS_OST)+wid*2048;
    #pragma unroll
    for(int r=0;r<16;++r){const int orow=crow(r,hi);
      #pragma unroll
      for(int d0=0;d0<2;++d0)stg[orow*64+d0*32+r32]=__float2bfloat16(o[d0][r]*rli[r]);}
    asm volatile("s_waitcnt lgkmcnt(0)":::"memory");
    #pragma unroll
    for(int i=0;i<4;++i){const int row=i*8+(lane>>3),ch=lane&7; const u32x4 v=*(const u32x4*)(stg+row*64+ch*8); ATTN_STORE16(Ow+(long)row*DM+ch*8,v);} }
  asm volatile("s_waitcnt lgkmcnt(0)\n\ts_barrier":::"memory");
  #undef DMA_K
  #undef DMA_V
  #undef CMASK
  #undef START
  #undef RESC
  #undef ROT
}
constexpr int ATTN_LDS_BYTES=LDS_BYTES;
#undef SBAR
#undef WAIT_BAR
}
#define LAS __attribute__((address_space(3)))
typedef unsigned short bf16_t;
typedef unsigned u32x4 __attribute__((ext_vector_type(4)));
typedef unsigned u32x2 __attribute__((ext_vector_type(2)));
typedef float f32x4 __attribute__((ext_vector_type(4)));
typedef short bf16x8 __attribute__((ext_vector_type(8)));

#ifndef MK_MULTI
#define MK_MULTI 0
#endif
#ifndef PROBE
#define PROBE 0
#endif
#ifndef PH_MASK
#define PH_MASK 0xFFFF
#endif
#define PHON(k) ((MASK >> (k)) & 1)
constexpr int NWAVES = 8, NTHR = 512, LDS_BYTES = 155648;
constexpr int NPH = 1 + 4 * 6 + 1;
constexpr size_t WS_HB = 0;
constexpr size_t WS_XB = WS_HB + (size_t)GT * PITCH * 2;
constexpr size_t WS_W1 = WS_XB + (size_t)GT * DMODEL * 2;
constexpr size_t WS_WB = WS_W1 + (size_t)5632 * 1024 * 2;
constexpr size_t WS_WO = WS_WB + (size_t)1024 * 1536 * 2;
constexpr size_t WS_WU = WS_WO + (size_t)1024 * 1024 * 2;
constexpr size_t WS_WD = WS_WU + (size_t)5632 * 1024 * 2;
constexpr size_t WS_HALO = WS_WD + (size_t)1024 * 2816 * 2;
constexpr size_t WS_SSQ1 = WS_HALO + (size_t)512 * PITCH * 2;
constexpr size_t WS_SSQ2 = WS_SSQ1 + (size_t)GT * 4;
constexpr size_t WS_BAR = WS_SSQ2 + (size_t)GT * 4;
constexpr size_t WS_END = WS_BAR + 16384;
static_assert(WS_END <= 268435456, "workspace map exceeds 256 MiB");

struct Params { const float* in[22]; float* out; unsigned char* ws; int lo, hi; };
enum { I_XP = 0, I_XS, I_RELB, I_N1G, I_WIN, I_LNG, I_LNB, I_WSP, I_BSP, I_SINK, I_QNG, I_KNG, I_WGATE, I_BGATE, I_WBR, I_WOUT, I_N2G, I_WUP, I_CW, I_CB, I_WDN, I_FING };

__device__ __forceinline__ const float* inp(const Params& P, int i) { asm volatile("" : "+s"(i)); return P.in[i]; }
__device__ __forceinline__ float wave_sum(float v) {
#pragma unroll
    for (int o = 1; o < 64; o <<= 1) v += __shfl_xor(v, o);
    return v;
}
__device__ __forceinline__ float bflo(unsigned w) { return __uint_as_float(w << 16); }
__device__ __forceinline__ float bfhi(unsigned w) { return __uint_as_float(w & 0xffff0000u); }
__device__ __forceinline__ unsigned short f2bf1(float f) { return (unsigned short)(pg8::cvt_pk_bf16(f, 0.f) & 0xffffu); }

struct WTile { const float* W; const float* gk; bf16_t* WT; int K, N, k0, n0, drow0; };
__device__ __forceinline__ WTile wprep_desc(const Params& P, unsigned char* ws, int l, int it) {
    WTile d; int r = it;
    const float* g1 = inp(P, I_N1G) + l * 1024; const float* g2 = inp(P, I_N2G) + l * 1024;
    if (r < 640) { const int kb = r / 40, nb = r % 40, sb = nb >> 1; const int db = sb < 4 ? sb : sb < 8 ? sb + 8 : sb < 12 ? sb - 4 : sb < 14 ? sb + 4 : sb < 18 ? sb - 6 : sb;
        d.W = inp(P, I_WIN) + (size_t)l * 1024 * 2560; d.K = 1024; d.N = 2560; d.k0 = kb * 64; d.n0 = nb * 64; d.gk = g1; d.WT = (bf16_t*)(ws + WS_W1); d.drow0 = db * 128 + (nb & 1) * 64; return d; } r -= 640;
    if (r < 768) { const int kb = r / 48, nb = r % 48; d.W = inp(P, I_WGATE) + (size_t)l * 1024 * 3072; d.K = 1024; d.N = 3072; d.k0 = kb * 64; d.n0 = nb * 64; d.gk = g1; d.WT = (bf16_t*)(ws + WS_W1); d.drow0 = 2560 + nb * 64; return d; } r -= 768;
    if (r < 384) { const int kb = r / 16, nb = r % 16; d.W = inp(P, I_WBR) + (size_t)l * 1536 * 1024; d.K = 1536; d.N = 1024; d.k0 = kb * 64; d.n0 = nb * 64; d.gk = nullptr; d.WT = (bf16_t*)(ws + WS_WB); d.drow0 = nb * 64; return d; } r -= 384;
    if (r < 256) { const int kb = r / 16, nb = r % 16; d.W = inp(P, I_WOUT) + (size_t)l * 1024 * 1024; d.K = 1024; d.N = 1024; d.k0 = kb * 64; d.n0 = nb * 64; d.gk = nullptr; d.WT = (bf16_t*)(ws + WS_WO); d.drow0 = nb * 64; return d; } r -= 256;
    if (r < 1408) { const int kb = r / 88, nb = r % 88; const int nv = nb >= 44 ? nb - 44 : nb;
        d.W = inp(P, I_WUP) + (size_t)l * 1024 * 5632; d.K = 1024; d.N = 5632; d.k0 = kb * 64; d.n0 = nb * 64; d.gk = g2; d.WT = (bf16_t*)(ws + WS_WU); d.drow0 = 256 * (nv >> 1) + (nb >= 44 ? 128 : 0) + 64 * (nv & 1); return d; } r -= 1408;
    { const int kb = r / 16, nb = r % 16; d.W = inp(P, I_WDN) + (size_t)l * 2816 * 1024; d.K = 2816; d.N = 1024; d.k0 = kb * 64; d.n0 = nb * 64; d.gk = nullptr; d.WT = (bf16_t*)(ws + WS_WD); d.drow0 = nb * 64; return d; }
}
__device__ __forceinline__ void wprep_load(const WTile& d, float (&v)[8], int tid) {
#pragma unroll
    for (int i = 0; i < 8; ++i) { const int kk = i * 8 + (tid >> 6), nn = tid & 63; float x = d.W[(size_t)(d.k0 + kk) * d.N + d.n0 + nn]; if (d.gk) x *= d.gk[d.k0 + kk]; v[i] = x; }
}
__device__ __forceinline__ void ph_wprep(const Params& P, int bid, int G, unsigned char* ws, int l, LAS unsigned char* lds, int tid, const int it_lo = 0, const int it_hi = 4160) {
    asm volatile("" : "+v"(tid)); asm volatile("" : "+s"(bid)); asm volatile("" : "+s"(G));
    LAS float* scr = (LAS float*)lds;
    int it = it_lo + bid; if (it >= it_hi) return;
    WTile d = wprep_desc(P, ws, l, it); float v[8]; wprep_load(d, v, tid);
#pragma unroll 1
    for (;;) {
#pragma unroll
        for (int i = 0; i < 8; ++i) { const int kk = i * 8 + (tid >> 6), nn = tid & 63; scr[kk * 65 + nn] = v[i]; }
        __syncthreads();
        const WTile cur = d; const int nit = it + G; const bool more = nit < it_hi;
        if (more) { d = wprep_desc(P, ws, l, nit); wprep_load(d, v, tid); }
        { const int n = tid >> 3, c = tid & 7; const LAS float* s = scr + (8 * c) * 65 + n;
          u32x4 o; o.x = pg8::cvt_pk_bf16(s[0], s[65]); o.y = pg8::cvt_pk_bf16(s[130], s[195]); o.z = pg8::cvt_pk_bf16(s[260], s[325]); o.w = pg8::cvt_pk_bf16(s[390], s[455]);
          *(u32x4*)(cur.WT + (size_t)(cur.drow0 + n) * cur.K + cur.k0 + 8 * c) = o; }
        __syncthreads();
        if (!more) break;
        it = nit;
    }
}

__device__ __forceinline__ void ph_p1(int bid, int G, unsigned char* ws, const float* xsrc, int tid) {
    asm volatile("" : "+v"(tid)); asm volatile("" : "+s"(bid)); asm volatile("" : "+s"(G));
    const int lane = tid & 63, wave = tid >> 6; bf16_t* XB = (bf16_t*)(ws + WS_XB); float* ssq1 = (float*)(ws + WS_SSQ1); float* ssq2 = (float*)(ws + WS_SSQ2);
    const int NGW = G * NWAVES;
    for (int row = bid * NWAVES + wave; row < GT; row += 2 * NGW) {
        const int row2 = row + NGW; const bool has2 = row2 < GT;
        const f32x4* xr = (const f32x4*)(xsrc + (size_t)row * DMODEL) + lane; const f32x4* xr2 = (const f32x4*)(xsrc + (size_t)(has2 ? row2 : row) * DMODEL) + lane;
        f32x4 v[4], v2[4]; float s = 0.f, s2 = 0.f;
#pragma unroll
        for (int j = 0; j < 4; ++j) { v[j] = xr[64 * j]; v2[j] = xr2[64 * j]; }
#pragma unroll
        for (int j = 0; j < 4; ++j) { s += (v[j].x * v[j].x + v[j].y * v[j].y) + (v[j].z * v[j].z + v[j].w * v[j].w); s2 += (v2[j].x * v2[j].x + v2[j].y * v2[j].y) + (v2[j].z * v2[j].z + v2[j].w * v2[j].w); }
        s = wave_sum(s); s2 = wave_sum(s2);
        u32x2* o = (u32x2*)(XB + (size_t)row * DMODEL) + lane;
#pragma unroll
        for (int j = 0; j < 4; ++j) { u32x2 w; w.x = pg8::cvt_pk_bf16(v[j].x, v[j].y); w.y = pg8::cvt_pk_bf16(v[j].z, v[j].w); o[64 * j] = w; }
        if (lane == 0) { ssq1[row] = s; ssq2[row] = 0.f; }
        if (has2) {
            u32x2* o2 = (u32x2*)(XB + (size_t)row2 * DMODEL) + lane;
#pragma unroll
            for (int j = 0; j < 4; ++j) { u32x2 w; w.x = pg8::cvt_pk_bf16(v2[j].x, v2[j].y); w.y = pg8::cvt_pk_bf16(v2[j].z, v2[j].w); o2[64 * j] = w; }
            if (lane == 0) { ssq1[row2] = s2; ssq2[row2] = 0.f; }
        }
    }
}

__device__ __forceinline__ void mixer_a_item(const Params& P, int l, int it, int par, bf16_t* HB, LAS unsigned char* lds, int tid) {
    const int ch = it >> 3, g8 = it & 7, r0 = ch * 128, lane = tid & 63, w = tid >> 6;
    LAS bf16_t* vT = (LAS bf16_t*)(lds + 16384 + par * 17408);
    const float* wsp = inp(P, I_WSP) + (((size_t)l * 8 + g8) * 128 + 16 * w + (lane & 15)) * 128 + 8 * (lane >> 4);
    f32x4 araw[8];
#pragma unroll
    for (int ks = 0; ks < 4; ++ks) { araw[2 * ks] = *(const f32x4*)(wsp + ks * 32); araw[2 * ks + 1] = *(const f32x4*)(wsp + ks * 32 + 4); }
    bf16_t* ub = HB + (size_t)(r0 + 16 * w + (lane & 15)) * PITCH + COL_U + g8 * 64 + 4 * (lane >> 4);
    u32x2 uraw[4];
#pragma unroll
    for (int nb = 0; nb < 4; ++nb) uraw[nb] = *(const u32x2*)(ub + 16 * nb);
    const float bs1 = inp(P, I_BSP)[((size_t)l * 8 + g8) * 128 + 16 * w + (lane & 15)];
    {
        const int q = tid >> 2, part = tid & 3;
        const bf16_t* vp = HB + (size_t)(r0 + q) * PITCH + COL_VA + part * 128;
        const int c0 = part * 16; const bf16_t* gp = HB + (size_t)(r0 + q) * PITCH + COL_VA + g8 * 64 + c0;
        const float* lg = inp(P, I_LNG) + l * 512 + g8 * 64 + c0; const float* lb = inp(P, I_LNB) + l * 512 + g8 * 64 + c0;
        u32x4 sv[16], gvw[2]; f32x4 lgv[4], lbv[4];
#pragma unroll
        for (int i = 0; i < 16; ++i) sv[i] = *(const u32x4*)(vp + 8 * i);
#pragma unroll
        for (int hh = 0; hh < 2; ++hh) gvw[hh] = *(const u32x4*)(gp + 8 * hh);
#pragma unroll
        for (int i = 0; i < 4; ++i) { lgv[i] = *(const f32x4*)(lg + 4 * i); lbv[i] = *(const f32x4*)(lb + 4 * i); }
        __builtin_amdgcn_sched_barrier(0);
        float s = 0.f, s2 = 0.f;
#pragma unroll
        for (int i = 0; i < 16; ++i) {
#pragma unroll
            for (int e = 0; e < 4; ++e) { const float a = bflo(sv[i][e]), b = bfhi(sv[i][e]); s += a + b; s2 += a * a + b * b; } }
        s += __shfl_xor(s, 1); s += __shfl_xor(s, 2); s2 += __shfl_xor(s2, 1); s2 += __shfl_xor(s2, 2);
        const float mean = s * (1.0f / 512.0f), var = fmaxf(s2 * (1.0f / 512.0f) - mean * mean, 0.f), rstd = rsqrtf(var + EPSN);
#pragma unroll
        for (int hh = 0; hh < 2; ++hh) { const u32x4 wv = gvw[hh];
#pragma unroll
            for (int e = 0; e < 4; ++e) { const int i = hh * 8 + e * 2;
                const float ga = lgv[i >> 2][i & 3], gb = lgv[(i + 1) >> 2][(i + 1) & 3], ba = lbv[i >> 2][i & 3], bb = lbv[(i + 1) >> 2][(i + 1) & 3];
                const float y0 = (bflo(wv[e]) - mean) * rstd * ga + ba, y1 = (bfhi(wv[e]) - mean) * rstd * gb + bb;
                vT[(c0 + i) * 136 + q] = f2bf1(y0); vT[(c0 + i + 1) * 136 + q] = f2bf1(y1); } }
    }
    __builtin_amdgcn_sched_barrier(0);
    bf16x8 afr[4];
#pragma unroll
    for (int ks = 0; ks < 4; ++ks) { const u32x4 aw = pg8::pack8(araw[2 * ks], araw[2 * ks + 1]); afr[ks] = __builtin_bit_cast(bf16x8, aw); }
    __syncthreads();
    f32x4 acc[4];
#pragma unroll
    for (int nb = 0; nb < 4; ++nb) acc[nb] = (f32x4){0.f, 0.f, 0.f, 0.f};
#pragma unroll
    for (int ks = 0; ks < 4; ++ks) {
#pragma unroll
        for (int nb = 0; nb < 4; ++nb) { const bf16x8 b = *(const LAS bf16x8*)(vT + (16 * nb + (lane & 15)) * 136 + ks * 32 + 8 * (lane >> 4));
            acc[nb] = __builtin_amdgcn_mfma_f32_16x16x32_bf16(b, afr[ks], acc[nb], 0, 0, 0); }
        __builtin_amdgcn_sched_barrier(0);
    }
#pragma unroll
    for (int nb = 0; nb < 4; ++nb) {
        u32x2 o; o.x = pg8::cvt_pk_bf16(bflo(uraw[nb].x) * (acc[nb][0] + bs1), bfhi(uraw[nb].x) * (acc[nb][1] + bs1)); o.y = pg8::cvt_pk_bf16(bflo(uraw[nb].y) * (acc[nb][2] + bs1), bfhi(uraw[nb].y) * (acc[nb][3] + bs1));
        *(u32x2*)(ub + 16 * nb) = o;
        __builtin_amdgcn_sched_barrier(0); }
}
__device__ __forceinline__ void ph_p3a(const Params& P, int bid, int G, unsigned char* ws, int l, int g, LAS unsigned char* lds, int tid, const int mode = 0) {
    asm volatile("" : "+v"(tid)); asm volatile("" : "+s"(bid)); asm volatile("" : "+s"(G));
    bf16_t* HB = (bf16_t*)(ws + WS_HB);
    LAS float* tab = (LAS float*)lds;
    for (int e = tid; e < 1024; e += NTHR) { const int pos = e >> 4, i = e & 15; const float inv = __builtin_amdgcn_exp2f(-(float)i * (13.287712379549449f / 16.0f)), rev = (float)pos * inv * 0.15915494309189535f; tab[2 * e] = __builtin_amdgcn_cosf(rev); tab[2 * e + 1] = __builtin_amdgcn_sinf(rev); }
    __syncthreads();
    if (mode != 2) { int par = 0;
#pragma unroll 1
      for (int i = 0, it0 = bid; it0 < 1024; ++i, it0 += G) {
          int it = it0; if (G == 256) { const int x = bid & 7, j = (bid >> 3) + 32 * i; it = ((x * 16 + (j >> 3)) << 3) + (j & 7); }
          mixer_a_item(P, l, it, par, HB, lds, tid); par ^= 1; } }
    __syncthreads();
    const int S = g == 0 ? 2048 : 4096;
    if (mode != 1)
    for (int idx = bid * NTHR + tid; idx < GT * 20; idx += G * NTHR) {
        const int half = idx & 1, th = idx >> 1, t = th / 10, hh = th - t * 10; const bool isq = hh < 8;
        bf16_t* p = HB + (size_t)t * PITCH + (isq ? COL_QC + hh * 64 : COL_KC + (hh - 8) * 64) + half * 32;
        const float* gain = (isq ? inp(P, I_QNG) : inp(P, I_KNG)) + l * 64 + half * 32; const float sc = isq ? QK_C2 : 1.0f;
        float x[32]; float ssq = 0.f;
        u32x4 xw[4]; f32x4 gvv[8];
#pragma unroll
        for (int i = 0; i < 4; ++i) xw[i] = *(const u32x4*)(p + 8 * i);
#pragma unroll
        for (int i = 0; i < 8; ++i) gvv[i] = *(const f32x4*)(gain + 4 * i);
        __builtin_amdgcn_sched_barrier(0);
#pragma unroll
        for (int i = 0; i < 4; ++i) {
#pragma unroll
            for (int e = 0; e < 4; ++e) { x[8 * i + 2 * e] = bflo(xw[i][e]); x[8 * i + 2 * e + 1] = bfhi(xw[i][e]); } }
#pragma unroll
        for (int i = 0; i < 32; ++i) ssq += x[i] * x[i];
        ssq += __shfl_xor(ssq, 1);
        const float rstd = rsqrtf(ssq * (1.0f / 64.0f) + EPSN);
#pragma unroll
        for (int i = 0; i < 8; ++i) {
#pragma unroll
            for (int e = 0; e < 4; ++e) x[4 * i + e] = x[4 * i + e] * rstd * gvv[i][e]; }
        const int ts = t & (S - 1), pos = half ? (ts & 63) : (ts >> 6);
#pragma unroll
        for (int i = 0; i < 16; ++i) { const float cs = tab[(pos * 16 + i) * 2], sn = tab[(pos * 16 + i) * 2 + 1]; const float x1 = x[i], x2 = x[16 + i];
            x[i] = (x1 * cs - x2 * sn) * sc; x[16 + i] = (x2 * cs + x1 * sn) * sc; }
#pragma unroll
        for (int i = 0; i < 4; ++i) { u32x4 wv;
#pragma unroll
            for (int e = 0; e < 4; ++e) wv[e] = pg8::cvt_pk_bf16(x[8 * i + 2 * e], x[8 * i + 2 * e + 1]);
            *(u32x4*)(p + 8 * i) = wv; }
    }
}

__device__ __forceinline__ int t5_bucket(int rel) {
    const int n = rel < 0 ? -rel : rel; int b;
    if (n < 8) b = n; else { b = 8 + (n >= 12) + (n >= 16) + (n >= 23) + (n >= 32) + (n >= 46) + (n >= 64) + (n >= 91); }
    return b + (rel > 0 ? 16 : 0);
}
constexpr int BT_OFF = 86016, BT_PITCH = 260;
__device__ __forceinline__ void ph_p3b(const Params& P, int bid, int G, unsigned char* ws, int l, int g, unsigned char* lds_gen, LAS unsigned char* lds, int tid, const int which = 0) {
    asm volatile("" : "+v"(tid)); asm volatile("" : "+s"(bid)); asm volatile("" : "+s"(G));
    using abf = attn_body::bf16;
    LAS float* bt = (LAS float*)(lds + BT_OFF);
    for (int e = tid; e < 8 * 257; e += NTHR) { const int h = e / 257, i = e - h * 257; bt[h * BT_PITCH + i] = inp(P, I_RELB)[t5_bucket(i - 128) * 8 + h] * 1.4426950408889634f; }
    __syncthreads();
    const abf* HB = (const abf*)(ws + WS_HB); abf* HBw = (abf*)(ws + WS_HB);
    const int S = g == 0 ? 2048 : 4096;
    if (which != 2)
    for (int u = bid; u < 512; u += G) {
        const int h = u & 7, r = (u >> 3) * 256, q0 = r & (S - 1); const long rowbase = r - q0;
        attn_body::attn_unit<8, 0>(rowbase, q0, 0, S / 64, HB + COL_QC + h * 64, HB + COL_KC + (h >> 2) * 64, HB + COL_VC + (h >> 2) * 64, HBw + COL_QC + h * 64, (char*)lds_gen, (attn_body::lds_fptr)bt, 0.f, tid);
    }
    if (which != 1)
    for (int u = bid; u < 512; u += G) {
        const int h = u & 7, r = (u >> 3) * 256, q0 = r & (S - 1); const long rowbase = r - q0;
        const int kt0 = q0 >= 128 ? q0 - 128 : 0, kend = (q0 + 384 <= S) ? q0 + 384 : S;
        attn_body::attn_unit<8, 1>(rowbase, q0, kt0, (kend - kt0) / 64, HB + COL_QB + h * 64, HB + COL_KB + (h >> 2) * 64, HB + COL_VB + (h >> 2) * 64, HBw + COL_QB + h * 64, (char*)lds_gen,
                                   (attn_body::lds_fptr)(bt + h * BT_PITCH), inp(P, I_SINK)[l * 8 + h] * 1.4426950408889634f, tid);
    }
}

__device__ __forceinline__ void unpack8(const u32x4 w, float (&o)[8]) {
#pragma unroll
    for (int e = 0; e < 4; ++e) { o[2 * e] = bflo(w[e]); o[2 * e + 1] = bfhi(w[e]); }
}
__device__ __forceinline__ void ph_conv(const Params& P, int bid, int G, unsigned char* ws, int l, int g, int tid) {
    asm volatile("" : "+v"(tid)); asm volatile("" : "+s"(bid)); asm volatile("" : "+s"(G));
    bf16_t* HB = (bf16_t*)(ws + WS_HB); const bf16_t* halo = (const bf16_t*)(ws + WS_HALO);
    const int S = g == 0 ? 2048 : 4096;
    const float* cw = inp(P, I_CW) + (size_t)l * 3 * 5632; const float* cb = inp(P, I_CB) + (size_t)l * 5632;
    for (int gt = bid * NTHR + tid; gt < 256 * 352; gt += G * NTHR) {
        const int rb = gt / 352, ci = gt - rb * 352, r0 = rb * 64, cg0 = ci * 8, cv0 = DFF + ci * 8;
        float wg[3][8], wv[3][8], bg[8], bv[8];
#pragma unroll
        for (int k = 0; k < 3; ++k)
#pragma unroll
            for (int e = 0; e < 8; ++e) { wg[k][e] = cw[k * 5632 + cg0 + e]; wv[k][e] = cw[k * 5632 + cv0 + e]; }
#pragma unroll
        for (int e = 0; e < 8; ++e) { bg[e] = cb[cg0 + e]; bv[e] = cb[cv0 + e]; }
        const bool topz = (r0 & (S - 1)) == 0, botz = ((r0 + 64) & (S - 1)) == 0;
        float pgt[8], pvl[8], cgt[8], cvl[8];
        if (topz) {
#pragma unroll
            for (int e = 0; e < 8; ++e) { pgt[e] = 0.f; pvl[e] = 0.f; }
        } else { const bf16_t* hp = halo + (size_t)((rb - 1) * 2 + 1) * PITCH; unpack8(*(const u32x4*)(hp + cg0), pgt); unpack8(*(const u32x4*)(hp + cv0), pvl); }
        { const bf16_t* rp = HB + (size_t)r0 * PITCH; unpack8(*(const u32x4*)(rp + cg0), cgt); unpack8(*(const u32x4*)(rp + cv0), cvl); }
#pragma unroll 1
        for (int rr = 0; rr < 64; rr += 8) {
            u32x4 ng[8], nv[8];
#pragma unroll
            for (int j = 0; j < 8; ++j) {
                if (rr + j + 1 < 64) { const bf16_t* rp = HB + (size_t)(r0 + rr + j + 1) * PITCH; ng[j] = *(const u32x4*)(rp + cg0); nv[j] = *(const u32x4*)(rp + cv0); }
                else if (botz) { ng[j] = (u32x4){0u, 0u, 0u, 0u}; nv[j] = (u32x4){0u, 0u, 0u, 0u}; }
                else { const bf16_t* hp = halo + (size_t)((rb + 1) * 2) * PITCH; ng[j] = *(const u32x4*)(hp + cg0); nv[j] = *(const u32x4*)(hp + cv0); }
            }
#pragma unroll
            for (int j = 0; j < 8; ++j) {
                float ngt[8], nvl[8]; unpack8(ng[j], ngt); unpack8(nv[j], nvl);
                float o[8];
#pragma unroll
                for (int e = 0; e < 8; ++e) { const float a = pgt[e] * wg[0][e] + cgt[e] * wg[1][e] + ngt[e] * wg[2][e] + bg[e]; const float b = pvl[e] * wv[0][e] + cvl[e] * wv[1][e] + nvl[e] * wv[2][e] + bv[e];
                    o[e] = pg8::silu_f(a) * b; pgt[e] = cgt[e]; pvl[e] = cvl[e]; cgt[e] = ngt[e]; cvl[e] = nvl[e]; }
                u32x4 w; w.x = pg8::cvt_pk_bf16(o[0], o[1]); w.y = pg8::cvt_pk_bf16(o[2], o[3]); w.z = pg8::cvt_pk_bf16(o[4], o[5]); w.w = pg8::cvt_pk_bf16(o[6], o[7]);
                *(u32x4*)(HB + (size_t)(r0 + rr + j) * PITCH + cg0) = w;
            }
        }
    }
}

__device__ __forceinline__ void ph_final(const Params& P, int bid, int G, int tid) {
    asm volatile("" : "+v"(tid)); asm volatile("" : "+s"(bid)); asm volatile("" : "+s"(G));
    const int lane = tid & 63, wave = tid >> 6; const f32x4* gp = (const f32x4*)inp(P, I_FING) + lane;
    const int NGW = G * NWAVES;
    f32x4 gv[4];
#pragma unroll
    for (int j = 0; j < 4; ++j) gv[j] = gp[64 * j];
    for (int row = bid * NWAVES + wave; row < 2 * GT; row += 2 * NGW) {
        const int row2 = row + NGW; const bool has2 = row2 < 2 * GT;
        f32x4* xr = (f32x4*)(P.out + (size_t)row * DMODEL) + lane; f32x4* xr2 = (f32x4*)(P.out + (size_t)(has2 ? row2 : row) * DMODEL) + lane;
        f32x4 v[4], v2[4]; float s = 0.f, s2 = 0.f;
#pragma unroll
        for (int j = 0; j < 4; ++j) { v[j] = xr[64 * j]; v2[j] = xr2[64 * j]; }
#pragma unroll
        for (int j = 0; j < 4; ++j) { s += (v[j].x * v[j].x + v[j].y * v[j].y) + (v[j].z * v[j].z + v[j].w * v[j].w); s2 += (v2[j].x * v2[j].x + v2[j].y * v2[j].y) + (v2[j].z * v2[j].z + v2[j].w * v2[j].w); }
        const float rs = rsqrtf(wave_sum(s) * (1.0f / 1024.0f) + EPSN), rs2 = rsqrtf(wave_sum(s2) * (1.0f / 1024.0f) + EPSN);
#pragma unroll
        for (int j = 0; j < 4; ++j) xr[64 * j] = v[j] * rs * gv[j];
        if (has2) {
#pragma unroll
            for (int j = 0; j < 4; ++j) xr2[64 * j] = v2[j] * rs2 * gv[j];
        }
    }
}

#define XB_TMO      128
#define XB_XCNT(j)  (256  + 64 * (j))
#define XB_XSUB(j)  (1280 + 64 * (j))
#define XB_XGEN(j)  (2304 + 64 * (j))
#define XB_TOP      3328
#define XB_TOPGEN   3392
#define XCD_BAR_WORDS 3456
#define XB_SPIN_CAP (1u << 22)
__device__ __forceinline__ unsigned xb_ld(unsigned* p)              { return __hip_atomic_load(p, __ATOMIC_RELAXED, __HIP_MEMORY_SCOPE_AGENT); }
__device__ __forceinline__ unsigned xb_add(unsigned* p, unsigned v) { return __hip_atomic_fetch_add(p, v, __ATOMIC_RELAXED, __HIP_MEMORY_SCOPE_AGENT); }
__device__ __forceinline__ unsigned xb_xcc_id() { return (unsigned)__builtin_amdgcn_s_getreg((3 << 11) | 20) & 0xFu; }
#define XB_SPIN(cond, bar) do { unsigned _sp = 0; while (cond) { __builtin_amdgcn_s_sleep(1); \
    if ((++_sp & 255u) == 0u) { if (xb_ld(&(bar)[XB_TMO])) break; if (_sp > XB_SPIN_CAP) { atomicAdd(&(bar)[XB_TMO], 1u); break; } } } } while (0)
__device__ __forceinline__ void xcd_barrier_complete(unsigned* bar, unsigned x, unsigned G, unsigned& nloc, unsigned& nx) {
    unsigned sum, cnt, mine, sp = 0u;
    for (;;) {
        sum = 0u; cnt = 0u; mine = 0u;
#pragma unroll
        for (unsigned j = 0; j < 16; ++j) { const unsigned c = xb_ld(&bar[XB_XCNT(j)]); sum += c; cnt += (c > 0u) ? 1u : 0u; mine = (j == x) ? c : mine; }
        if (sum == G) break;
        __builtin_amdgcn_s_sleep(1);
        if ((++sp & 255u) == 0u) { if (xb_ld(&bar[XB_TMO])) break; if (sp > XB_SPIN_CAP) { atomicAdd(&bar[XB_TMO], 1u); break; } }
    }
    nloc = mine > 0u ? mine : 1u; nx = cnt > 0u ? cnt : 1u;
}
__device__ __forceinline__ void grid_bar(unsigned* bar, volatile LAS unsigned* st, unsigned G, int tid) {
    asm volatile("s_waitcnt vmcnt(0) lgkmcnt(0)" ::: "memory");
    __syncthreads();
    if (tid == 0) {
        const unsigned x = xb_xcc_id();
        __builtin_amdgcn_s_waitcnt(0);
        unsigned nloc = st[0], nx = st[1];
        if (nloc == 0u) { xcd_barrier_complete(bar, x, G, nloc, nx); st[0] = nloc; st[1] = nx; }
        const unsigned old = xb_add(&bar[XB_XSUB(x)], 1u);
        const unsigned gen = old / nloc;
        if (old + 1u == (gen + 1u) * nloc) {
            __builtin_amdgcn_fence(__ATOMIC_RELEASE, "agent");
            asm volatile("s_waitcnt vmcnt(0)" ::: "memory");
            const unsigned og = xb_add(&bar[XB_TOP], 1u);
            const unsigned tg = og / nx;
            if (og + 1u == (tg + 1u) * nx) xb_add(&bar[XB_TOPGEN], 1u);
            else XB_SPIN(xb_ld(&bar[XB_TOPGEN]) == tg, bar);
            __builtin_amdgcn_fence(__ATOMIC_ACQUIRE, "agent");
            xb_add(&bar[XB_XGEN(x)], 1u);
            asm volatile("s_waitcnt vmcnt(0)" ::: "memory");
        } else {
            XB_SPIN(xb_ld(&bar[XB_XGEN(x)]) == gen, bar);
            __builtin_amdgcn_fence(__ATOMIC_ACQUIRE, "agent");
            asm volatile("s_waitcnt vmcnt(0)" ::: "memory");
        }
    }
    __syncthreads();
}
constexpr int BARST_OFF = LDS_BYTES - 64;
#define PH_BEGIN(I) { int lo = P.lo, hi = P.hi; asm volatile("" : "+v"(lo)); asm volatile("" : "+v"(hi));   if ((I) >= lo && (I) < hi) { \
        int tid = wave_s * 64 + (int)__builtin_amdgcn_mbcnt_hi(~0u, __builtin_amdgcn_mbcnt_lo(~0u, 0u)); asm volatile("" : "+v"(tid)); \
        unsigned char* ws = P.ws; asm volatile("" : "+s"(ws)); int G = gridDim.x; asm volatile("" : "+s"(G)); int bid = blockIdx.x; asm volatile("" : "+s"(bid)); \
        if ((I) > lo) grid_bar((unsigned*)(ws + WS_BAR), (volatile LAS unsigned*)(lds + BARST_OFF), (unsigned)G, tid); \
        bf16_t* HB = (bf16_t*)(ws + WS_HB); bf16_t* XB = (bf16_t*)(ws + WS_XB); float* ssq1 = (float*)(ws + WS_SSQ1); float* ssq2 = (float*)(ws + WS_SSQ2); (void)HB; (void)XB; (void)ssq1; (void)ssq2; (void)tid; (void)G; (void)bid;
#define PH_END } }
#define BAR2(k) grid_bar((unsigned*)(ws + WS_BAR), (volatile LAS unsigned*)(lds + BARST_OFF), (unsigned)G, tid)
template <int MASK, int L, int GR> __device__ __forceinline__ void run_lg(const Params& P, const int wave_s, unsigned char* lds_raw, LAS unsigned char* lds) {
    constexpr int I0 = 1 + (L * 2 + GR) * 6;
    PH_BEGIN(I0 + 0) if (PHON(1)) {
        pg8::Gemm gm{XB, (const bf16_t*)(ws + WS_W1), 1024, 1024, 1024}; pg8::Order S; S.init(GT, 5632, G, bid, 1, 0);
        { LAS float* rt = (LAS float*)(lds + 139264);
          for (int e = tid; e < 1024; e += NTHR) { const int pos = e >> 4, i = e & 15; const float inv = __builtin_amdgcn_exp2f(-(float)i * (13.287712379549449f / 16.0f)), rev = (float)pos * inv * 0.15915494309189535f; rt[2 * e] = __builtin_amdgcn_cosf(rev); rt[2 * e + 1] = __builtin_amdgcn_sinf(rev); }
          __syncthreads(); }
        pg8::Epi1 E{HB, ssq1, inp(P, I_BGATE) + L * 3072, inp(P, I_QNG) + L * 64, inp(P, I_KNG) + L * 64, (PG8_LAS float*)(lds + 131072), (const PG8_LAS float*)(lds + 139264), (GR == 0 ? 2048 : 4096) - 1};
        pg8::gemm_phase<pg8::Epi1, pg8::Order, true, true>(lds, gm, S, E, tid);
        if (L == 1 && GR == 0 && PHON(9)) { __syncthreads(); ph_wprep(P, bid, G, ws, 1, lds, tid, 3456, 4160); }
        if (PROBE == 2) { __syncthreads(); pg8::gemm_phase<pg8::Epi1, pg8::Order, true, true>(lds, gm, S, E, tid); } } PH_END
    PH_BEGIN(I0 + 1) if (PHON(3)) {
        ph_p3a(P, bid, G, ws, L, GR, lds, tid, 1); __syncthreads();
        ph_p3b(P, bid, G, ws, L, GR, lds_raw, lds, tid); } PH_END
    PH_BEGIN(I0 + 2) if (PHON(4)) {
        pg8::Gemm gm{HB, (const bf16_t*)(ws + WS_WB), PITCH, 1536, 512}; pg8::Order S; S.init(GT, 1024, G, bid, 3, 512);
        pg8::Epi4 E{HB};
        pg8::gemm_phase<pg8::Epi4, pg8::Order, true, true>(lds, gm, S, E, tid);
        if (PROBE == 4) { __syncthreads(); pg8::gemm_phase<pg8::Epi4, pg8::Order, true, true>(lds, gm, S, E, tid); } } PH_END
    PH_BEGIN(I0 + 3) if (PHON(5)) {
        float* xdst = P.out + (size_t)GR * GT * DMODEL; const float* xsrc = L == 0 ? inp(P, GR) : (const float*)xdst;
        pg8::Gemm gm{HB + COL_MERGED, (const bf16_t*)(ws + WS_WO), PITCH, 1024, 1024}; pg8::Order S; S.init(GT, 1024, G, bid, 1, 0);
        pg8::Epi5 E{xsrc, xdst, XB, ssq2};
        pg8::gemm_phase<pg8::Epi5, pg8::Order, true, true>(lds, gm, S, E, tid); } PH_END
    PH_BEGIN(I0 + 4) if (PHON(6)) {
        pg8::Gemm gm{XB, (const bf16_t*)(ws + WS_WU), 1024, 1024, 1024}; pg8::Order S; S.init_ovl(65, 5632, G, bid);
        pg8::Epi7f E{HB, ssq2, inp(P, I_CW) + (size_t)L * 3 * 5632, inp(P, I_CB) + (size_t)L * 5632, (PG8_LAS float*)(lds + 131072), (GR == 0 ? 2048 : 4096) - 1, GT};
        pg8::gemm_phase<pg8::Epi7f, pg8::Order, true, true>(lds, gm, S, E, tid); } PH_END
    PH_BEGIN(I0 + 5) if (PHON(5)) {
        float* xdst = P.out + (size_t)GR * GT * DMODEL;
        pg8::Gemm gm{HB, (const bf16_t*)(ws + WS_WD), PITCH, 2816, 2816}; pg8::Order S; S.init(GT, 1024, G, bid, 1, 0);
        pg8::Epi5 E{xdst, xdst, nullptr, nullptr};
        pg8::gemm_phase<pg8::Epi5, pg8::Order, true, true>(lds, gm, S, E, tid);
        if (!(L == 1 && GR == 1)) {
            constexpr int NL = GR == 0 ? L : 1, NG = GR == 0 ? 1 : 0;
            const float* xn = NL == 0 ? inp(P, NG) : (const float*)(P.out + (size_t)NG * GT * DMODEL);
            __syncthreads();
            if (L == 0 && GR == 1 && PHON(9)) ph_wprep(P, bid, G, ws, 1, lds, tid, 0, 3456);
            if (PHON(0)) ph_p1(bid, G, ws, xn, tid); } } PH_END
}
template <int MASK> __device__ __forceinline__ void fwd_body(const Params& P) {
    extern __shared__ __attribute__((aligned(16))) unsigned char lds_raw[];
    LAS unsigned char* lds = (LAS unsigned char*)lds_raw;
    const int wave_s = __builtin_amdgcn_readfirstlane((int)threadIdx.x >> 6);
    { if (threadIdx.x == 0) { ((volatile LAS unsigned*)(lds + BARST_OFF))[0] = 0u; ((volatile LAS unsigned*)(lds + BARST_OFF))[1] = 0u; (void)xb_add((unsigned*)(P.ws + WS_BAR) + XB_XCNT(xb_xcc_id()), 1u); } __syncthreads(); }
    if (P.hi < 0) { cg::grid_group grid = cg::this_grid(); grid.sync(); }
    PH_BEGIN(0) { if (PHON(9)) ph_wprep(P, bid, G, ws, 0, lds, tid); if (PHON(0)) ph_p1(bid, G, ws, inp(P, 0), tid); } PH_END
    run_lg<MASK, 0, 0>(P, wave_s, lds_raw, lds);
    run_lg<MASK, 0, 1>(P, wave_s, lds_raw, lds);
    run_lg<MASK, 1, 0>(P, wave_s, lds_raw, lds);
    run_lg<MASK, 1, 1>(P, wave_s, lds_raw, lds);
    PH_BEGIN(NPH - 1) if (PHON(10)) ph_final(P, bid, G, tid); PH_END
}

#if MK_MULTI
#define DEFK(name, mask) __global__ void __launch_bounds__(NTHR, 2) name(Params P) { fwd_body<mask>(P); }
DEFK(fwd_k0, 0x001) DEFK(fwd_k1, 0x002) DEFK(fwd_k2, 0x004) DEFK(fwd_k3, 0x008) DEFK(fwd_k4, 0x010) DEFK(fwd_k5, 0x020) DEFK(fwd_k6, 0x040) DEFK(fwd_k7, 0x080) DEFK(fwd_k9, 0x200) DEFK(fwd_k10, 0x400)
#define fwd_kernel fwd_k3
#else
__global__ void __launch_bounds__(NTHR, 2) fwd_kernel(Params P) { fwd_body<PH_MASK>(P); }
#endif

extern "C" void kernel_launch(void* const* d_in, const int* in_sizes, int n_in, void* d_out, int out_size, void* d_ws, size_t ws_size, hipStream_t stream) {
    static int grid = 0;
    if (grid == 0) {
        if (n_in != 22 || out_size != 2 * GT * DMODEL || ws_size < WS_END) { fprintf(stderr, "kernel_launch: unexpected shapes (n_in %d out %d ws %zu)\n", n_in, out_size, ws_size); grid = -1; return; }
        int dev = 0, cus = 0, per_cu = 0;
        if (hipGetDevice(&dev) != hipSuccess || hipDeviceGetAttribute(&cus, hipDeviceAttributeMultiprocessorCount, dev) != hipSuccess) { grid = -1; return; }
        if (hipFuncSetAttribute((const void*)fwd_kernel, hipFuncAttributeMaxDynamicSharedMemorySize, LDS_BYTES) != hipSuccess) { fprintf(stderr, "kernel_launch: hipFuncSetAttribute failed\n"); grid = -1; return; }
        if (hipOccupancyMaxActiveBlocksPerMultiprocessor(&per_cu, (const void*)fwd_kernel, NTHR, LDS_BYTES) != hipSuccess || per_cu < 1) { fprintf(stderr, "kernel_launch: occupancy query says %d\n", per_cu); per_cu = 1; }
        (void)hipGetLastError();
        grid = cus;
    }
    if (grid < 0) return;
    (void)hipMemsetAsync((unsigned char*)d_ws + WS_BAR, 0, 16384, stream);
    Params p{};
    for (int i = 0; i < 22; ++i) p.in[i] = (const float*)d_in[i];
    p.out = (float*)d_out; p.ws = (unsigned char*)d_ws;
#if MK_MULTI
    typedef void (*kfn)(Params);
    const kfn kf[11] = {fwd_k0, fwd_k1, fwd_k2, fwd_k3, fwd_k4, fwd_k5, fwd_k6, fwd_k5, fwd_k5, fwd_k9, fwd_k10};
    for (int i = 0; i < 11; ++i) (void)hipFuncSetAttribute((const void*)kf[i], hipFuncAttributeMaxDynamicSharedMemorySize, LDS_BYTES);
    for (int i = 0; i < NPH; ++i) { p.lo = i; p.hi = i + 1;
        const int r = i % 17; const int k = (i == NPH - 1) ? 10 : (r == 0 ? 9 : (r - 1) % 8);
        hipLaunchKernelGGL(kf[k], dim3(grid), dim3(NTHR), LDS_BYTES, stream, p);
        if (PROBE == 8 && k == 3) { for (int d = 2; d >= 0; --d) { p.lo = i - d; p.hi = i - d + 1; hipLaunchKernelGGL(kf[k - d], dim3(grid), dim3(NTHR), LDS_BYTES, stream, p); } } }
#else
    p.lo = 0; p.hi = NPH;
    void* args[] = {&p};
    hipError_t e = hipLaunchCooperativeKernel((const void*)fwd_kernel, dim3(grid), dim3(NTHR), args, LDS_BYTES, stream);
    if (e != hipSuccess) fprintf(stderr, "cooperative launch failed: %s (grid %d)\n", hipGetErrorString(e), grid);
#endif
}
```
